# Optimizing an MI355X kernel written in HIP

```python
import jax, jax.numpy as jnp
from jax import lax
import numpy as np

D_MODEL = 2048
BATCH = 2
SEQ = 4096
DEPTH = 1

D_MIX = D_MODEL
D_CONV = D_MIX // 2
CONV_WIDTH = 3
N_HEADS = 8
N_KV_HEADS = 2
HEAD_DIM = (D_MIX - D_CONV) // N_HEADS
KV_REP = N_HEADS // N_KV_HEADS
ROPE_DIM = HEAD_DIM // 4
ROPE_THETA = 500000.0
IDX_HEADS = 16
IDX_DIM = 64
IDX_ROPE_DIM = IDX_DIM // 4
TOPK_MAX = 256
Q_BLOCK = 128
IN_SPLITS = (D_CONV, D_CONV, D_CONV,
             N_HEADS * HEAD_DIM, N_KV_HEADS * HEAD_DIM, N_KV_HEADS * HEAD_DIM,
             IDX_HEADS * IDX_DIM, IDX_DIM, IDX_HEADS)
D_IN = 3 * D_CONV + (N_HEADS + 2 * N_KV_HEADS) * HEAD_DIM + IDX_HEADS * IDX_DIM + IDX_DIM + IDX_HEADS
N_EXPERTS = 32
TOP_K = 4
D_FF = D_MODEL
SWIGLU_LIMIT = 7.0
SWIGLU_ALPHA = 1.702
MOE_BLOCK = 256
EPS = 1e-6

kernel_name = "hymba_conv_dsa_moe_layer"


def rmsnorm(x, g):
    xf = x.astype(jnp.float32)
    y = xf * lax.rsqrt(jnp.mean(xf * xf, axis=-1, keepdims=True) + EPS)
    return (y * g.astype(jnp.float32)).astype(x.dtype)


def partial_rope(x, pos, rot_dim):
    half = rot_dim // 2
    inv_freq = ROPE_THETA ** (-jnp.arange(half, dtype=jnp.float32) / half)
    ang = pos.astype(jnp.float32)[..., None] * inv_freq
    cos = jnp.cos(ang)[:, :, None, :]
    sin = jnp.sin(ang)[:, :, None, :]
    xr = x[..., :rot_dim].astype(jnp.float32)
    x1, x2 = xr[..., :half], xr[..., half:]
    rot = jnp.concatenate([x1 * cos - x2 * sin, x2 * cos + x1 * sin], axis=-1).astype(x.dtype)
    return jnp.concatenate([rot, x[..., rot_dim:]], axis=-1)


def short_conv_mixer(b_gate, c_gate, u, conv_w):
    v = c_gate * u
    y = lax.conv_general_dilated(v, conv_w, window_strides=(1,), padding=[(CONV_WIDTH - 1, 0)],
                                 dimension_numbers=('NWC', 'WIO', 'NWC'),
                                 feature_group_count=D_CONV)
    return b_gate * y


def dsa_attention(q, k, v, q_idx, k_idx, w_idx):
    B, S = q.shape[0], q.shape[1]
    topk = min(TOPK_MAX, S // 4)
    n_blocks = S // Q_BLOCK
    key_pos = jnp.arange(S)
    scale = HEAD_DIM ** -0.5

    def block(i):
        t0 = i * Q_BLOCK
        qb = lax.dynamic_slice_in_dim(q, t0, Q_BLOCK, axis=1)
        qib = lax.dynamic_slice_in_dim(q_idx, t0, Q_BLOCK, axis=1)
        wb = lax.dynamic_slice_in_dim(w_idx, t0, Q_BLOCK, axis=1)
        qpos = t0 + jnp.arange(Q_BLOCK)
        causal = key_pos[None, :] <= qpos[:, None]
        dots = jnp.einsum('bqhd,bsd->bqhs', qib, k_idx).astype(jnp.float32)
        score = jnp.einsum('bqh,bqhs->bqs', wb.astype(jnp.float32), jax.nn.relu(dots))
        score = jnp.where(causal[None], score, -jnp.inf)
        _, sel = lax.top_k(score, topk)
        valid = sel <= qpos[None, :, None]
        k_sel = jax.vmap(lambda kb, ib: kb[ib])(k, sel)
        v_sel = jax.vmap(lambda vb, ib: vb[ib])(v, sel)
        qg = qb.reshape(B, Q_BLOCK, N_KV_HEADS, KV_REP, HEAD_DIM)
        logits = jnp.einsum('bqgrd,bqkgd->bqgrk', qg, k_sel).astype(jnp.float32) * scale
        logits = jnp.where(valid[:, :, None, None, :], logits, -jnp.inf)
        p = jax.nn.softmax(logits, axis=-1).astype(v.dtype)
        o = jnp.einsum('bqgrk,bqkgd->bqgrd', p, v_sel)
        return o.reshape(B, Q_BLOCK, N_HEADS * HEAD_DIM)

    out = lax.map(block, jnp.arange(n_blocks))
    return out.transpose(1, 0, 2, 3).reshape(B, S, N_HEADS * HEAD_DIM)


def hybrid_mixer(h, positions, w_in, conv_w, g_conv_out, g_attn_out, w_out):
    B, S, _ = h.shape
    proj = h @ w_in
    split_at = [int(s) for s in np.cumsum(IN_SPLITS)[:-1]]
    b_g, c_g, u, q, k, v, q_i, k_i, w_i = jnp.split(proj, split_at, axis=-1)
    y_conv = short_conv_mixer(b_g, c_g, u, conv_w)
    q = partial_rope(q.reshape(B, S, N_HEADS, HEAD_DIM), positions, ROPE_DIM)
    k = partial_rope(k.reshape(B, S, N_KV_HEADS, HEAD_DIM), positions, ROPE_DIM)
    v = v.reshape(B, S, N_KV_HEADS, HEAD_DIM)
    q_i = partial_rope(q_i.reshape(B, S, IDX_HEADS, IDX_DIM), positions, IDX_ROPE_DIM)
    k_i = partial_rope(k_i.reshape(B, S, 1, IDX_DIM), positions, IDX_ROPE_DIM)[:, :, 0]
    y_attn = dsa_attention(q, k, v, q_i, k_i, w_i)
    merged = jnp.concatenate([rmsnorm(y_conv, g_conv_out), rmsnorm(y_attn, g_attn_out)], axis=-1)
    return merged @ w_out


def clamped_swiglu(gu):
    gate = jnp.minimum(gu[..., ::2], SWIGLU_LIMIT)
    up = jnp.clip(gu[..., 1::2], -SWIGLU_LIMIT, SWIGLU_LIMIT)
    return gate * jax.nn.sigmoid(SWIGLU_ALPHA * gate) * (up + 1.0)


def moe_ffn(h, w_router, b_router, w_gate_up, b_gate_up, w_down, b_down):
    B, S, D = h.shape
    N = B * S
    NK = N * TOP_K
    xf = h.reshape(N, D)
    logits = (xf @ w_router + b_router).astype(jnp.float32)
    top_logit, top_idx = lax.top_k(logits, TOP_K)
    gates = jax.nn.softmax(top_logit, axis=-1)
    flat_e = top_idx.reshape(NK)
    flat_tok = jnp.arange(NK, dtype=jnp.int32) // TOP_K
    order = jnp.argsort(flat_e)
    sorted_e = flat_e[order]
    sorted_tok = flat_tok[order]
    sorted_gate = gates.reshape(NK)[order].astype(h.dtype)
    counts = jnp.zeros((N_EXPERTS,), jnp.int32).at[flat_e].add(1)
    starts = jnp.cumsum(counts) - counts
    padded = (counts + MOE_BLOCK - 1) // MOE_BLOCK * MOE_BLOCK
    pad_ends = jnp.cumsum(padded)
    pad_starts = pad_ends - padded
    dest = pad_starts[sorted_e] + (jnp.arange(NK, dtype=jnp.int32) - starts[sorted_e])
    n_blocks = -(-NK // MOE_BLOCK) + N_EXPERTS
    P = n_blocks * MOE_BLOCK
    row_tok = jnp.zeros((P,), jnp.int32).at[dest].set(sorted_tok)
    row_valid = jnp.zeros((P,), bool).at[dest].set(True)
    x_rows = jnp.where(row_valid[:, None], xf[row_tok], 0).reshape(n_blocks, MOE_BLOCK, D)
    block_e = jnp.minimum(jnp.searchsorted(pad_ends, jnp.arange(n_blocks) * MOE_BLOCK, side='right'),
                          N_EXPERTS - 1)

    def expert_block(args):
        xb, e = args
        gu = xb @ w_gate_up[e] + b_gate_up[e]
        return clamped_swiglu(gu) @ w_down[e] + b_down[e]

    y_rows = lax.map(expert_block, (x_rows, block_e)).reshape(P, D)
    contrib = y_rows[dest] * sorted_gate[:, None]
    out = jnp.zeros((N, D), h.dtype).at[sorted_tok].add(contrib)
    return out.reshape(B, S, D)


def setup_inputs(seed: int = 0) -> dict:
    key = jax.random.key(seed)
    ks = jax.random.split(key, 24)
    f32 = jnp.float32
    nrm = lambda k, shape, s: jax.random.normal(k, shape, f32) * s
    gain = lambda k, shape: 1.0 + 0.02 * jax.random.normal(k, shape, f32)
    L = DEPTH
    x = jax.random.normal(ks[0], (BATCH, SEQ, D_MODEL), f32)
    c = jax.random.normal(ks[1], (BATCH, D_MODEL), f32)
    offset = jax.random.randint(ks[2], (BATCH, 1), 0, 1024, dtype=jnp.int32)
    positions = offset + jnp.arange(SEQ, dtype=jnp.int32)[None, :]
    return {
        "x": x, "c": c, "positions": positions,
        "w_ada": nrm(ks[3], (L, D_MODEL, 6 * D_MODEL), 0.2 * D_MODEL ** -0.5),
        "b_ada": nrm(ks[4], (L, 6 * D_MODEL), 0.01),
        "g_pre_mix": gain(ks[5], (L, D_MODEL)),
        "g_post_mix": gain(ks[6], (L, D_MODEL)),
        "w_in": nrm(ks[7], (L, D_MODEL, D_IN), D_MODEL ** -0.5),
        "conv_w": nrm(ks[8], (L, CONV_WIDTH, 1, D_CONV), CONV_WIDTH ** -0.5),
        "g_conv_out": gain(ks[9], (L, D_CONV)),
        "g_attn_out": gain(ks[10], (L, N_HEADS * HEAD_DIM)),
        "w_out": nrm(ks[11], (L, D_MIX, D_MODEL), D_MIX ** -0.5),
        "g_pre_ffn": gain(ks[12], (L, D_MODEL)),
        "g_post_ffn": gain(ks[13], (L, D_MODEL)),
        "w_router": nrm(ks[14], (L, D_MODEL, N_EXPERTS), D_MODEL ** -0.5),
        "b_router": nrm(ks[15], (L, N_EXPERTS), 0.01),
        "w_gate_up": nrm(ks[16], (L, N_EXPERTS, D_MODEL, 2 * D_FF), D_MODEL ** -0.5),
        "b_gate_up": nrm(ks[17], (L, N_EXPERTS, 2 * D_FF), 0.01),
        "w_down": nrm(ks[18], (L, N_EXPERTS, D_FF, D_MODEL), D_FF ** -0.5),
        "b_down": nrm(ks[19], (L, N_EXPERTS, D_MODEL), 0.01),
    }


def reference(x, c, positions, w_ada, b_ada, g_pre_mix, g_post_mix, w_in, conv_w, g_conv_out,
              g_attn_out, w_out, g_pre_ffn, g_post_ffn, w_router, b_router, w_gate_up, b_gate_up,
              w_down, b_down):
    for l in range(DEPTH):
        ada = jax.nn.silu(c) @ w_ada[l] + b_ada[l]
        sh1, sc1, gt1, sh2, sc2, gt2 = [a[:, None, :] for a in jnp.split(ada, 6, axis=-1)]
        h = rmsnorm(x, g_pre_mix[l]) * (1.0 + sc1) + sh1
        mix = hybrid_mixer(h, positions, w_in[l], conv_w[l], g_conv_out[l], g_attn_out[l], w_out[l])
        x = x + gt1 * rmsnorm(mix, g_post_mix[l])
        h = rmsnorm(x, g_pre_ffn[l]) * (1.0 + sc2) + sh2
        y = moe_ffn(h, w_router[l], b_router[l], w_gate_up[l], b_gate_up[l], w_down[l], b_down[l])
        x = x + gt2 * rmsnorm(y, g_post_ffn[l])
    return x
```

```cpp
#include <hip/hip_runtime.h>
#include <cstdint>
#include <cstddef>
#include <cstdio>

#define NTOK 8192
#define SEQ 4096
#define NB 2
#define DM 2048
#define DCONV 1024
#define NH 8
#define NKV 2
#define HD 128
#define IH 16
#define IDIM 64
#define TOPK 256
#define DIN 5712
#define NE 32
#define TK 4
#define DFF 2048
#define NROWS (NTOK * TK)
#define O_BG 0
#define O_CG 1024
#define O_U 2048
#define O_Q 3072
#define O_K 4096
#define O_V 4352
#define O_QI 4608
#define O_KI 5632
#define O_WI 5696
#define A_SH1 0
#define A_SC1 2048
#define A_GT1 4096
#define A_SH2 6144
#define A_SC2 8192
#define A_GT2 10240
#define NT 512
#define ADA_KC 8

#define LAS __attribute__((address_space(3)))

__device__ __constant__ float c_invf16[16] = {1.000000000e+00f, 4.403665960e-01f, 1.939227432e-01f, 8.539710194e-02f, 3.760603070e-02f, 1.656044088e-02f, 7.292664610e-03f, 3.211446106e-03f,
                                               1.414213562e-03f, 6.227724371e-04f, 2.742481884e-04f, 1.207697351e-04f, 5.318295734e-05f, 2.341999971e-05f, 1.031338525e-05f, 4.541670478e-06f};

#define XB_TMO      128
#define XB_XCNT(j)  (256  + 64 * (j))
#define XB_XSUB(j)  (1280 + 64 * (j))
#define XB_XGEN(j)  (2304 + 64 * (j))
#define XB_TOP      3328
#define XB_TOPGEN   3392
#define XCD_BAR_WORDS 3456
#define XB_SPIN_CAP (1u << 18)

__device__ __forceinline__ unsigned xb_ld(unsigned* p)              { return __hip_atomic_load(p, __ATOMIC_RELAXED, __HIP_MEMORY_SCOPE_AGENT); }
__device__ __forceinline__ unsigned xb_add(unsigned* p, unsigned v) { return __hip_atomic_fetch_add(p, v, __ATOMIC_RELAXED, __HIP_MEMORY_SCOPE_AGENT); }
__device__ __forceinline__ unsigned xb_xcc_id() { return (unsigned)__builtin_amdgcn_s_getreg((3 << 11) | 20) & 0xFu; }
#define XB_SPIN(cond, bar) do { unsigned _sp = 0; while (cond) { __builtin_amdgcn_s_sleep(1); \
    if ((++_sp & 255u) == 0u) { if (xb_ld(&(bar)[XB_TMO])) break; if (_sp > XB_SPIN_CAP) { atomicAdd(&(bar)[XB_TMO], 1u); break; } } } } while (0)

struct XcdBarrier { unsigned* bar; unsigned x; volatile LAS unsigned* st; };

__device__ __forceinline__ XcdBarrier xcd_barrier_post(unsigned* bar, volatile LAS unsigned* st) {
    XcdBarrier b; b.bar = bar; b.x = xb_xcc_id(); b.st = st;
    if (threadIdx.x == 0) (void)xb_add(&bar[XB_XCNT(b.x)], 1u);
    return b;
}
__device__ __forceinline__ void xcd_barrier_complete(unsigned* bar, unsigned x, unsigned& nloc, unsigned& nx) {
    const unsigned G = gridDim.x * gridDim.y * gridDim.z;
    unsigned sum, cnt, mine, sp = 0u;
    for (;;) {
        sum = 0u; cnt = 0u; mine = 0u;
#pragma unroll
        for (unsigned j = 0; j < 16; ++j) { const unsigned c = xb_ld(&bar[XB_XCNT(j)]); sum += c; cnt += (c > 0u) ? 1u : 0u; mine = (j == x) ? c : mine; }
        if (sum == G) break;
        __builtin_amdgcn_s_sleep(1);
        if ((++sp & 255u) == 0u) { if (xb_ld(&bar[XB_TMO])) break; if (sp > XB_SPIN_CAP) { atomicAdd(&bar[XB_TMO], 1u); break; } }
    }
    nloc = mine > 0u ? mine : 1u; nx = cnt > 0u ? cnt : 1u;
}
__device__ __forceinline__ void xcd_barrier(const XcdBarrier& b) {
    asm volatile("s_waitcnt vmcnt(0)" ::: "memory");
    __syncthreads();
    if (threadIdx.x == 0) {
        unsigned* bar = b.bar;
        __builtin_amdgcn_s_waitcnt(0);
        unsigned nloc = b.st[0], nx = b.st[1];
        if (nloc == 0u) { xcd_barrier_complete(bar, b.x, nloc, nx); b.st[0] = nloc; b.st[1] = nx; }
        const unsigned old = xb_add(&bar[XB_XSUB(b.x)], 1u);
        const unsigned gen = old / nloc;
        if (old + 1u == (gen + 1u) * nloc) {
            __builtin_amdgcn_fence(__ATOMIC_RELEASE, "agent");
            asm volatile("s_waitcnt vmcnt(0)" ::: "memory");
            const unsigned og = xb_add(&bar[XB_TOP], 1u);
            const unsigned tg = og / nx;
            if (og + 1u == (tg + 1u) * nx) xb_add(&bar[XB_TOPGEN], 1u);
            else XB_SPIN(xb_ld(&bar[XB_TOPGEN]) == tg, bar);
            __builtin_amdgcn_fence(__ATOMIC_ACQUIRE, "agent");
            xb_add(&bar[XB_XGEN(b.x)], 1u);
            asm volatile("s_waitcnt vmcnt(0)" ::: "memory");
        } else {
            XB_SPIN(xb_ld(&bar[XB_XGEN(b.x)]) == gen, bar);
            __builtin_amdgcn_fence(__ATOMIC_ACQUIRE, "agent");
            asm volatile("s_waitcnt vmcnt(0)" ::: "memory");
        }
    }
    __syncthreads();
}


typedef unsigned short f16_t;
typedef _Float16 f16x8 __attribute__((ext_vector_type(8)));
typedef _Float16 f16x2 __attribute__((ext_vector_type(2)));
typedef float f32x4 __attribute__((ext_vector_type(4)));
typedef unsigned u32x4 __attribute__((ext_vector_type(4)));
typedef unsigned u32x2 __attribute__((ext_vector_type(2)));
typedef int v4i_t __attribute__((ext_vector_type(4)));
typedef short s16x4_t __attribute__((ext_vector_type(4)));
typedef short s16x8_t __attribute__((ext_vector_type(8)));
typedef int v8i_t __attribute__((ext_vector_type(8)));
__device__ __forceinline__ unsigned pk4q(float a, float b, float c, float d) { int w = __builtin_amdgcn_cvt_pk_fp8_f32(a, b, 0, false); w = __builtin_amdgcn_cvt_pk_fp8_f32(c, d, w, true); return (unsigned)w; }
__device__ __forceinline__ unsigned pk2h(float lo, float hi) { f16x2 h; h.x = (_Float16)lo; h.y = (_Float16)hi; return __builtin_bit_cast(unsigned, h); }

namespace pg8 {
constexpr int BM = 256, BK = 64, HALF = 128, HTB = HALF * BK * 2, STAGE_BYTES = 8 * HTB, NXCD = 8, WGM = 8;
__host__ __device__ __forceinline__ int lds_byte(int r, int c) { const int st = (r >> 4) * 2 + (c >> 5), rr = r & 15, cc = c & 31, ob = rr * 64 + cc * 2; return st * 1024 + (ob ^ (((ob >> 9) & 1) << 5)); }
__host__ __device__ __forceinline__ void stage_rc(int b, int& R, int& C) { const int st = b / 1024, sb = b % 1024, swz = sb ^ (((sb >> 9) & 1) << 5); R = (st >> 1) * 16 + swz / 64; C = (st & 1) * 32 + (swz % 64) / 2; }
__host__ __device__ __forceinline__ int perm32(int rho) { const int n = rho >> 4, i = rho & 15; return 8 * (i >> 2) + 4 * n + (i & 3); }

struct Unit { int pm, pn, e; size_t boff; };
struct Gemm { const f16_t* A; const f16_t* Bt; int M, N, K; };

struct StaticOrder {
    int nM, nN, nwg, G, c;
    __host__ __device__ void init(int M, int N, int G_, int c_) { nM = M / BM; nN = N / BM; nwg = nM * nN; G = G_; c = c_; }
    __host__ __device__ bool next(int i, Unit& u) const {
        const long L = (long)i * G + c; if (L >= nwg) return false;
        int wgid = (int)L; { const int q = nwg / NXCD, r = nwg % NXCD, xcd = wgid % NXCD, off = wgid / NXCD; wgid = (xcd < r ? xcd * (q + 1) : r * (q + 1) + (xcd - r) * q) + off; }
        const int nig = WGM * nN, gid = wgid / nig, fm = gid * WGM, gsz = (nM - fm) < WGM ? (nM - fm) : WGM;
        u.pm = fm + ((wgid % nig) % gsz); u.pn = (wgid % nig) / gsz; u.boff = 0; u.e = 0; return true;
    }
    __device__ __forceinline__ unsigned a_off(const Unit& u, int h, int R, int K) const { return (unsigned)((u.pm * BM + h * HALF + R) * K) * 2u; }
    __device__ __forceinline__ void a_ready(const Unit&) const {}
    __device__ __forceinline__ void done(const Unit&) const {}
};

struct EpiF32G {
    static constexpr bool PERM = false, AFTER_DRAIN = false;
    float* C; int ldc; int ncols;
    __device__ __forceinline__ void operator()(const f32x4 (&acc)[2][2][4][2], const Unit& u, int wr, int wc, int fr, int fq) const {
        const int row0 = u.pm * BM + wr * 64 + fr, col0 = u.pn * BM + wc * 32 + 4 * fq;
#pragma unroll
        for (int ai = 0; ai < 2; ++ai)
#pragma unroll
            for (int m = 0; m < 4; ++m) { float* rowp = C + (size_t)(row0 + ai * HALF + m * 16) * ldc + col0;
#pragma unroll
                for (int bj = 0; bj < 2; ++bj)
#pragma unroll
                    for (int n = 0; n < 2; ++n) if (col0 + bj * HALF + n * 16 < ncols) *(f32x4*)(rowp + bj * HALF + n * 16) = acc[ai][bj][m][n]; }
    }
};

struct EpiF16G {
    static constexpr bool PERM = true, AFTER_DRAIN = false;
    f16_t* C; int ldc; int ncols;
    __device__ __forceinline__ void operator()(const f32x4 (&acc)[2][2][4][2], const Unit& u, int wr, int wc, int fr, int fq) const {
        const int row0 = u.pm * BM + wr * 64 + fr, col0 = u.pn * BM + wc * 32 + 8 * fq;
#pragma unroll
        for (int ai = 0; ai < 2; ++ai)
#pragma unroll
            for (int m = 0; m < 4; ++m) { f16_t* rowp = C + (size_t)(row0 + ai * HALF + m * 16) * ldc + col0;
#pragma unroll
                for (int bj = 0; bj < 2; ++bj) if (col0 + bj * HALF < ncols) { const f32x4 v0 = acc[ai][bj][m][0], v1 = acc[ai][bj][m][1];
                    u32x4 w; w.x = pk2h(v0[0], v0[1]); w.y = pk2h(v0[2], v0[3]); w.z = pk2h(v1[0], v1[1]); w.w = pk2h(v1[2], v1[3]);
                    *(u32x4*)(rowp + bj * HALF) = w; } }
    }
};
struct EpiF16Bias {
    static constexpr bool PERM = true, AFTER_DRAIN = false;
    f16_t* C; int ldc; const float* bias; int nbias;
    __device__ __forceinline__ void operator()(const f32x4 (&acc)[2][2][4][2], const Unit& u, int wr, int wc, int fr, int fq) const {
        const int row0 = u.pm * BM + wr * 64 + fr, col0 = u.pn * BM + wc * 32 + 8 * fq;
        const float* bp = bias + (size_t)u.e * nbias + col0;
        f32x4 bv[2][2];
#pragma unroll
        for (int bj = 0; bj < 2; ++bj)
#pragma unroll
            for (int n = 0; n < 2; ++n) bv[bj][n] = *(const f32x4*)(bp + bj * HALF + 4 * n);
#pragma unroll
        for (int ai = 0; ai < 2; ++ai)
#pragma unroll
            for (int m = 0; m < 4; ++m) { f16_t* rowp = C + (size_t)(row0 + ai * HALF + m * 16) * ldc + col0;
#pragma unroll
                for (int bj = 0; bj < 2; ++bj) { const f32x4 v0 = acc[ai][bj][m][0] + bv[bj][0], v1 = acc[ai][bj][m][1] + bv[bj][1];
                    u32x4 w; w.x = pk2h(v0[0], v0[1]); w.y = pk2h(v0[2], v0[3]); w.z = pk2h(v1[0], v1[1]); w.w = pk2h(v1[2], v1[3]);
                    *(u32x4*)(rowp + bj * HALF) = w; } }
    }
};
struct EpiF16BiasN {
    static constexpr bool PERM = false, AFTER_DRAIN = false;
    f16_t* C; int ldc; const float* bias; int nbias;
    __device__ __forceinline__ void operator()(const f32x4 (&acc)[2][2][4][2], const Unit& u, int wr, int wc, int fr, int fq) const {
        const int row0 = u.pm * BM + wr * 64 + fr, col0 = u.pn * BM + wc * 32 + 4 * fq;
        const float* bp = bias + (size_t)u.e * nbias + col0;
        f32x4 bv[2][2];
#pragma unroll
        for (int bj = 0; bj < 2; ++bj)
#pragma unroll
            for (int n = 0; n < 2; ++n) bv[bj][n] = *(const f32x4*)(bp + bj * HALF + 16 * n);
#pragma unroll
        for (int ai = 0; ai < 2; ++ai)
#pragma unroll
            for (int m = 0; m < 4; ++m) { f16_t* rowp = C + (size_t)(row0 + ai * HALF + m * 16) * ldc + col0;
#pragma unroll
                for (int bj = 0; bj < 2; ++bj)
#pragma unroll
                    for (int n = 0; n < 2; ++n) { const f32x4 v = acc[ai][bj][m][n] + bv[bj][n]; u32x2 w; w.x = pk2h(v[0], v[1]); w.y = pk2h(v[2], v[3]); *(u32x2*)(rowp + bj * HALF + 16 * n) = w; } }
    }
};
template <bool GATHER> struct GroupedOrder {
    int nN, G, c, ntiles; const LAS int* te; const LAS int* tj; const LAS int* cn; const int* lists; size_t estride;
    __device__ __forceinline__ bool next(int i, Unit& u) const {
        const long L = (long)i * G + c; if (L >= (long)ntiles * nN) return false;
        u.pm = (int)(L / nN); u.pn = (int)(L % nN); u.e = te[u.pm]; u.boff = (size_t)u.e * estride; return true;
    }
    __device__ __forceinline__ unsigned a_off(const Unit& u, int h, int R, int K) const {
        if (GATHER) { const int i = tj[u.pm] * BM + h * HALF + R; const int src = (i < cn[u.e]) ? (lists[(size_t)u.e * NTOK + i] >> 2) : 0; return (unsigned)(src * K) * 2u; }
        return (unsigned)((u.pm * BM + h * HALF + R) * K) * 2u;
    }
    __device__ __forceinline__ void a_ready(const Unit&) const {}
    __device__ __forceinline__ void done(const Unit&) const {}
};
struct DynOrderG {
    int nN, ntiles; const LAS int* te; const LAS int* tj; const LAS int* cn; const int* lists; size_t estride;
    unsigned* qhead; unsigned* ready; unsigned need; unsigned* tmo; volatile LAS unsigned* slot; mutable int seen_e;
    __device__ __forceinline__ bool next(int i, Unit& u) const {
        if (threadIdx.x == 0) slot[i & 1] = __hip_atomic_fetch_add(qhead, 1u, __ATOMIC_RELAXED, __HIP_MEMORY_SCOPE_AGENT);
        asm volatile("s_waitcnt lgkmcnt(0)" ::: "memory"); __builtin_amdgcn_s_barrier(); asm volatile("" ::: "memory");
        const unsigned L = slot[i & 1];
        if (L >= (unsigned)(ntiles * nN)) return false;
        u.pm = (int)(L / (unsigned)nN); u.pn = (int)(L % (unsigned)nN); u.e = te[u.pm]; u.boff = (size_t)u.e * estride; return true;
    }
    __device__ __forceinline__ unsigned a_off(const Unit& u, int h, int R, int K) const {
        const int i = tj[u.pm] * BM + h * HALF + R; const int src = (i < cn[u.e]) ? (lists[(size_t)u.e * NTOK + i] >> 2) : 0; return (unsigned)(src * K) * 2u;
    }
    __device__ __forceinline__ void a_ready(const Unit& u) const {
        if (u.e == seen_e) return;
        seen_e = u.e;
        if (threadIdx.x < 64) { unsigned sp = 0;
            while ((unsigned)__builtin_amdgcn_readfirstlane((int)__hip_atomic_load(ready + 64 * u.e, __ATOMIC_RELAXED, __HIP_MEMORY_SCOPE_AGENT)) < need) {
                __builtin_amdgcn_s_sleep(4);
                if ((++sp & 255u) == 0u) { if (__builtin_amdgcn_readfirstlane((int)__hip_atomic_load(tmo, __ATOMIC_RELAXED, __HIP_MEMORY_SCOPE_AGENT)) != 0) break;
                    if (sp > (1u << 17)) { if (threadIdx.x == 0) __hip_atomic_store(tmo, 1u, __ATOMIC_RELAXED, __HIP_MEMORY_SCOPE_AGENT); break; } } }
            __builtin_amdgcn_fence(__ATOMIC_ACQUIRE, "agent");
            asm volatile("s_waitcnt vmcnt(0)" ::: "memory"); }
        asm volatile("" ::: "memory"); __builtin_amdgcn_s_barrier(); asm volatile("" ::: "memory");
    }
    __device__ __forceinline__ void done(const Unit&) const {}
};
template <bool PERM_> struct EpiSwigluT {
    static constexpr bool PERM = PERM_, AFTER_DRAIN = false;
    f16_t* O; int ldo; const float* bias; int nbias;
    static __device__ __forceinline__ float act1(float g_, float u_) { const float gt = fminf(g_, 7.0f), up = fminf(fmaxf(u_, -7.0f), 7.0f);
        return gt * __builtin_amdgcn_rcpf(1.0f + __builtin_amdgcn_exp2f(gt * (-1.702f * 1.4426950408889634f))) * (up + 1.0f); }
    __device__ __forceinline__ void operator()(const f32x4 (&acc)[2][2][4][2], const Unit& u, int wr, int wc, int fr, int fq) const {
        const int row0 = u.pm * BM + wr * 64 + fr, col0 = u.pn * BM + wc * 32 + (PERM_ ? 8 : 4) * fq;
        const float* bp = bias + (size_t)u.e * nbias + col0;
        f32x4 bv[2][2];
#pragma unroll
        for (int bj = 0; bj < 2; ++bj)
#pragma unroll
            for (int n = 0; n < 2; ++n) bv[bj][n] = *(const f32x4*)(bp + bj * HALF + (PERM_ ? 4 : 16) * n);
#pragma unroll
        for (int ai = 0; ai < 2; ++ai)
#pragma unroll
            for (int m = 0; m < 4; ++m) { f16_t* rowp = O + (size_t)(row0 + ai * HALF + m * 16) * ldo + (col0 >> 1);
#pragma unroll
                for (int bj = 0; bj < 2; ++bj) { const f32x4 v0 = acc[ai][bj][m][0] + bv[bj][0], v1 = acc[ai][bj][m][1] + bv[bj][1];
                    const unsigned w0 = pk2h(act1(v0[0], v0[1]), act1(v0[2], v0[3])), w1 = pk2h(act1(v1[0], v1[1]), act1(v1[2], v1[3]));
                    if (PERM_) { u32x2 w; w.x = w0; w.y = w1; *(u32x2*)(rowp + bj * (HALF / 2)) = w; }
                    else { *(unsigned*)(rowp + bj * (HALF / 2)) = w0; *(unsigned*)(rowp + bj * (HALF / 2) + 8) = w1; } } }
    }
};
typedef EpiSwigluT<true> EpiSwiglu;
struct EpiSwigluQ {
    static constexpr bool PERM = true, AFTER_DRAIN = false;
    unsigned char* O; int ldo; const float* bias; int nbias;
    __device__ __forceinline__ void operator()(const f32x4 (&acc)[2][2][4][2], const Unit& u, int wr, int wc, int fr, int fq) const {
        const int row0 = u.pm * BM + wr * 64 + fr, col0 = u.pn * BM + wc * 32 + 8 * fq;
        const float* bp = bias + (size_t)u.e * nbias + col0;
        f32x4 bv[2][2];
#pragma unroll
        for (int bj = 0; bj < 2; ++bj)
#pragma unroll
            for (int n = 0; n < 2; ++n) bv[bj][n] = *(const f32x4*)(bp + bj * HALF + 4 * n);
#pragma unroll
        for (int ai = 0; ai < 2; ++ai)
#pragma unroll
            for (int m = 0; m < 4; ++m) { unsigned char* rowp = O + (size_t)(row0 + ai * HALF + m * 16) * ldo + (col0 >> 1);
#pragma unroll
                for (int bj = 0; bj < 2; ++bj) { const f32x4 v0 = acc[ai][bj][m][0] + bv[bj][0], v1 = acc[ai][bj][m][1] + bv[bj][1];
                    *(unsigned*)(rowp + bj * (HALF / 2)) = pk4q(EpiSwigluT<true>::act1(v0[0], v0[1]), EpiSwigluT<true>::act1(v0[2], v0[3]), EpiSwigluT<true>::act1(v1[0], v1[1]), EpiSwigluT<true>::act1(v1[2], v1[3])); } }
    }
};
struct EpiF32Bias {
    static constexpr bool PERM = false, AFTER_DRAIN = false;
    float* C; int ldc; const float* bias; int nbias;
    __device__ __forceinline__ void operator()(const f32x4 (&acc)[2][2][4][2], const Unit& u, int wr, int wc, int fr, int fq) const {
        const int row0 = u.pm * BM + wr * 64 + fr, col0 = u.pn * BM + wc * 32 + 4 * fq;
        const float* bp = bias + (size_t)u.e * nbias + col0;
        f32x4 bv[2][2];
#pragma unroll
        for (int bj = 0; bj < 2; ++bj)
#pragma unroll
            for (int n = 0; n < 2; ++n) bv[bj][n] = *(const f32x4*)(bp + bj * HALF + n * 16);
#pragma unroll
        for (int ai = 0; ai < 2; ++ai)
#pragma unroll
            for (int m = 0; m < 4; ++m) { float* rowp = C + (size_t)(row0 + ai * HALF + m * 16) * ldc + col0;
#pragma unroll
                for (int bj = 0; bj < 2; ++bj)
#pragma unroll
                    for (int n = 0; n < 2; ++n) *(f32x4*)(rowp + bj * HALF + n * 16) = acc[ai][bj][m][n] + bv[bj][n]; }
    }
};

template <class Epi, class Sched, bool BKN = false, bool FP8 = false, bool ALIGN_EPI = true>
__device__ __forceinline__ void gemm_phase(LAS unsigned char* lds, const Gemm g, const Sched& S, const Epi& E) {
    const int tid = threadIdx.x, wid = __builtin_amdgcn_readfirstlane(tid >> 6), lane = tid & 63, wr = wid >> 2, wc = wid & 3, fr = lane & 15, fq = lane >> 4;
    const int K = g.K, nt = K / BK;
    unsigned voffB[2]; int RA[2]; unsigned CA2[2];
#pragma unroll
    for (int i = 0; i < 2; ++i) { int R, C; stage_rc(tid * 16 + i * 8192, R, C); const int Rb = Epi::PERM ? ((R & ~31) + perm32(R & 31)) : R;
        RA[i] = R; CA2[i] = (unsigned)C * 2u; voffB[i] = (unsigned)(Rb * K + C) * 2u;
        if constexpr (BKN) { static_assert(!Epi::PERM, "BKN needs PERM == false"); const int q = tid + 512 * i, kr = q >> 4, c16 = q & 15, sw = (kr & 3) | (((kr >> 3) & 1) << 2);
            voffB[i] = (unsigned)(kr * g.N + ((((c16 >> 1) ^ sw) << 4) + ((c16 & 1) << 3))) * 2u; } }
    const size_t kstep = (size_t)(BK * 2);
    const size_t hstep = (size_t)HALF * K * 2;
    const size_t kstepB = BKN ? (size_t)BK * g.N * 2 : kstep, hstepB = BKN ? (size_t)256 : hstep, tstep = BKN ? (size_t)512 : 2 * hstep;
    const unsigned ldsw = (unsigned)wid * 1024u;
    const int aoff = lds_byte(wr * 64 + fr, fq * 8), boff = lds_byte(wc * 32 + fr, fq * 8);
    int btr[2];
    { const int q4 = (lane >> 2) & 3, p4 = lane & 3, sw = q4 | ((fq & 1) << 2);
#pragma unroll
      for (int ns = 0; ns < 2; ++ns) btr[ns] = (int)(uintptr_t)lds + 65536 + (8 * fq + q4) * 256 + ((((wc * 2 + ns) ^ sw)) << 5) + 8 * p4; }
#define PG8_SA(b, h) (((b) * 2 + (h)) * HTB)
#define PG8_SB(b, h) ((4 + (b) * 2 + (h)) * HTB)
#define PG8_STAGE(bufoff, ubase, off32, voff) do { _Pragma("unroll") for (int _i = 0; _i < 2; ++_i) \
        __builtin_amdgcn_global_load_lds((const unsigned*)((const char*)(ubase) + (unsigned)((voff)[_i] + (unsigned)(off32))), (LAS unsigned*)(lds + (bufoff) + ldsw + _i * 8192), 16, 0, 0); } while (0)
#define PG8_STAGEA(bufoff, koff, v0_, v1_) do { \
        __builtin_amdgcn_global_load_lds((const unsigned*)((const char*)g.A + (unsigned)((v0_) + (unsigned)(koff))), (LAS unsigned*)(lds + (bufoff) + ldsw), 16, 0, 0); \
        __builtin_amdgcn_global_load_lds((const unsigned*)((const char*)g.A + (unsigned)((v1_) + (unsigned)(koff))), (LAS unsigned*)(lds + (bufoff) + ldsw + 8192), 16, 0, 0); } while (0)
#define PG8_SETA(v, u) do { _Pragma("unroll") for (int h_ = 0; h_ < 2; ++h_) _Pragma("unroll") for (int i_ = 0; i_ < 2; ++i_) v[h_][i_] = S.a_off(u, h_, RA[i_], K) + CA2[i_]; } while (0)
#define PG8_LDA(dst, b, h) do { _Pragma("unroll") for (int m = 0; m < 4; ++m) _Pragma("unroll") for (int k = 0; k < 2; ++k) dst[m][k] = *(const LAS f16x8*)(lds + PG8_SA(b, h) + aoff + m * 2048 + k * 1024); } while (0)
#define PG8_TRRD(dst, addr, off) asm volatile("ds_read_b64_tr_b16 %0, %1 offset:%2" : "=&v"(dst) : "v"(addr), "i"(off) : "memory")
#define PG8_LDB(dst, b, h) do { if constexpr (BKN) { _Pragma("unroll") for (int n = 0; n < 2; ++n) _Pragma("unroll") for (int k = 0; k < 2; ++k) { s16x4_t lo_, hi_; \
            PG8_TRRD(lo_, btr[n], ((b) * 2 + (h)) * HTB + k * 8192); PG8_TRRD(hi_, btr[n], ((b) * 2 + (h)) * HTB + k * 8192 + 1024); \
            dst[n][k] = __builtin_bit_cast(f16x8, (s16x8_t){lo_[0], lo_[1], lo_[2], lo_[3], hi_[0], hi_[1], hi_[2], hi_[3]}); } } \
        else { _Pragma("unroll") for (int n = 0; n < 2; ++n) _Pragma("unroll") for (int k = 0; k < 2; ++k) dst[n][k] = *(const LAS f16x8*)(lds + PG8_SB(b, h) + boff + n * 2048 + k * 1024); } } while (0)
#define PG8_V8(x0, x1) __builtin_shufflevector(__builtin_bit_cast(v4i_t, x0), __builtin_bit_cast(v4i_t, x1), 0, 1, 2, 3, 4, 5, 6, 7)
#define PG8_MMA(ai, bj, At, Bt) do { __builtin_amdgcn_s_setprio(1); if constexpr (FP8) { _Pragma("unroll") for (int m = 0; m < 4; ++m) _Pragma("unroll") for (int n = 0; n < 2; ++n) \
            asm volatile("v_mfma_scale_f32_16x16x128_f8f6f4 %0, %1, %2, %0, %3, %4 op_sel_hi:[0,0,0]" : "+v"(acc[ai][bj][m][n]) : "v"(PG8_V8(Bt[n][0], Bt[n][1])), "v"(PG8_V8(At[m][0], At[m][1])), "v"(sclW), "v"(sclX)); } \
        else { _Pragma("unroll") for (int m = 0; m < 4; ++m) _Pragma("unroll") for (int n = 0; n < 2; ++n) _Pragma("unroll") for (int k = 0; k < 2; ++k) \
            acc[ai][bj][m][n] = __builtin_amdgcn_mfma_f32_16x16x32_f16(Bt[n][k], At[m][k], acc[ai][bj][m][n], 0, 0, 0); } __builtin_amdgcn_s_setprio(0); } while (0)
#define PG8_WAIT_V(n) asm volatile("s_waitcnt vmcnt(" #n ")" ::: "memory")
#define PG8_WAIT_L(n) asm volatile("s_waitcnt lgkmcnt(" #n ")" ::: "memory")
#define PG8_BAR __builtin_amdgcn_s_barrier()
#define PG8_SCHED __builtin_amdgcn_sched_barrier(0)
    Unit cur, nxt; int ui = 0;
    if (!S.next(0, cur)) return;
    f32x4 acc[2][2][4][2];
#pragma unroll
    for (int a = 0; a < 2; ++a)
#pragma unroll
        for (int b = 0; b < 2; ++b)
#pragma unroll
            for (int m = 0; m < 4; ++m)
#pragma unroll
                for (int n = 0; n < 2; ++n) acc[a][b][m][n] = (f32x4){0.f, 0.f, 0.f, 0.f};
    f16x8 At[4][2], B0[2][2], B1[2][2];
    const int sclW = 0x7A7A7A7A, sclX = 0x7F7F7F7F;
    unsigned vAc[2][2], vAn[2][2];
    PG8_SETA(vAc, cur);
    const char* cB = (const char*)g.Bt + cur.boff + (size_t)cur.pn * tstep;
    S.a_ready(cur);
    PG8_STAGE(PG8_SB(0, 0), cB, 0, voffB); PG8_STAGE(PG8_SB(0, 1), cB, hstepB, voffB); PG8_STAGEA(PG8_SA(0, 0), 0, vAc[0][0], vAc[0][1]); PG8_STAGEA(PG8_SA(0, 1), 0, vAc[1][0], vAc[1][1]);
    if (wr == 1) PG8_BAR;
    PG8_WAIT_V(2); PG8_BAR;
    PG8_STAGE(PG8_SB(1, 0), cB, kstepB, voffB); PG8_STAGEA(PG8_SA(1, 0), kstep, vAc[0][0], vAc[0][1]); PG8_STAGE(PG8_SB(1, 1), cB, hstepB + kstepB, voffB);
    PG8_WAIT_V(6); PG8_BAR;
    for (;;) {
        const bool has_next = S.next(ui + 1, nxt);
        if (has_next) { PG8_SETA(vAn, nxt); }
        else {
#pragma unroll
            for (int h_ = 0; h_ < 2; ++h_)
#pragma unroll
                for (int i_ = 0; i_ < 2; ++i_) vAn[h_][i_] = vAc[h_][i_]; }
        const char* nB = has_next ? (const char*)g.Bt + nxt.boff + (size_t)nxt.pn * tstep : cB;
        for (int t = 0; t < nt; t += 2) {
            const bool last = (t == nt - 2);
            const size_t k1 = (size_t)(t + 1) * kstep, k2 = last ? (size_t)0 : (size_t)(t + 2) * kstep, k3 = k2 + kstep;
            const unsigned w00 = last ? vAn[0][0] : vAc[0][0], w01 = last ? vAn[0][1] : vAc[0][1], w10 = last ? vAn[1][0] : vAc[1][0], w11 = last ? vAn[1][1] : vAc[1][1];
            const char* bb = last ? nB : cB; const unsigned o2 = last ? 0u : (unsigned)((size_t)(t + 2) * kstepB), o3 = o2 + (unsigned)kstepB;
            if (last && has_next) S.a_ready(nxt);
            PG8_LDB(B0, 0, 0); PG8_LDB(B1, 0, 1); PG8_SCHED; PG8_LDA(At, 0, 0); PG8_STAGEA(PG8_SA(1, 1), k1, vAc[1][0], vAc[1][1]);
            PG8_WAIT_V(8); PG8_WAIT_L(0); PG8_SCHED; PG8_BAR; PG8_MMA(0, 0, At, B0); PG8_MMA(0, 1, At, B1); PG8_BAR; PG8_SCHED;
            PG8_LDA(At, 0, 1); PG8_STAGE(PG8_SB(0, 0), bb, o2, voffB); PG8_STAGE(PG8_SB(0, 1), bb, o2 + (unsigned)hstepB, voffB); PG8_STAGEA(PG8_SA(0, 0), k2, w00, w01);
            PG8_WAIT_V(8); PG8_WAIT_L(0); PG8_BAR; PG8_MMA(1, 0, At, B0); PG8_MMA(1, 1, At, B1); PG8_BAR; PG8_SCHED;
            PG8_LDB(B0, 1, 0); PG8_LDB(B1, 1, 1); PG8_SCHED; PG8_LDA(At, 1, 0); PG8_STAGEA(PG8_SA(0, 1), k2, w10, w11);
            PG8_WAIT_V(8); PG8_WAIT_L(0); PG8_SCHED; PG8_BAR; PG8_MMA(0, 0, At, B0); PG8_MMA(0, 1, At, B1); PG8_BAR; PG8_SCHED;
            PG8_LDA(At, 1, 1); PG8_STAGE(PG8_SB(1, 0), bb, o3, voffB); PG8_STAGE(PG8_SB(1, 1), bb, o3 + (unsigned)hstepB, voffB); PG8_STAGEA(PG8_SA(1, 0), k3, w00, w01);
            PG8_WAIT_V(8); PG8_WAIT_L(0); PG8_BAR; PG8_MMA(1, 0, At, B0); PG8_MMA(1, 1, At, B1); PG8_BAR; PG8_SCHED;
        }
        if constexpr (ALIGN_EPI) { if (wr == 0) PG8_BAR; }
        if constexpr (FP8) { asm volatile("s_nop 15\n\ts_nop 15" ::: "memory"); }
        E(acc, cur, wr, wc, fr, fq); S.done(cur);
        if (!has_next) break;
#pragma unroll
        for (int a = 0; a < 2; ++a)
#pragma unroll
            for (int b = 0; b < 2; ++b)
#pragma unroll
                for (int m = 0; m < 4; ++m)
#pragma unroll
                    for (int n = 0; n < 2; ++n) acc[a][b][m][n] = (f32x4){0.f, 0.f, 0.f, 0.f};
        cur = nxt; cB = nB; ++ui;
#pragma unroll
        for (int h_ = 0; h_ < 2; ++h_)
#pragma unroll
            for (int i_ = 0; i_ < 2; ++i_) vAc[h_][i_] = vAn[h_][i_];
        if constexpr (ALIGN_EPI) { if (wr == 1) PG8_BAR; }
    }
    PG8_WAIT_V(0);
    if constexpr (!ALIGN_EPI) { if (wr == 0) PG8_BAR; }
    PG8_BAR;
#undef PG8_SA
#undef PG8_SB
#undef PG8_STAGE
#undef PG8_STAGEA
#undef PG8_SETA
#undef PG8_LDA
#undef PG8_LDB
#undef PG8_TRRD
#undef PG8_MMA
#undef PG8_V8
#undef PG8_WAIT_V
#undef PG8_WAIT_L
#undef PG8_BAR
#undef PG8_SCHED
}
}

__device__ __forceinline__ void transpose_item(const float* W, int K, int N, f16_t* WT, LAS float* scr, int nblk, int item, int lane) {
    const int kb = item / nblk, nb = item % nblk, k0 = 64 * kb, n0 = 64 * nb;
    const int kr = lane >> 4, nq = (lane & 15) * 4;
    const bool ok = (n0 + nq) < N;
    f32x4 v[16];
#pragma unroll
    for (int i = 0; i < 16; ++i) v[i] = ok ? *(const f32x4*)(W + (size_t)(k0 + 4 * i + kr) * N + n0 + nq) : (f32x4){0.f, 0.f, 0.f, 0.f};
#pragma unroll
    for (int i = 0; i < 16; ++i) { LAS float* d = scr + (4 * i + kr) * 65 + nq; d[0] = v[i][0]; d[1] = v[i][1]; d[2] = v[i][2]; d[3] = v[i][3]; }
    asm volatile("s_waitcnt lgkmcnt(0)" ::: "memory");
    const int c = lane & 7;
#pragma unroll
    for (int j = 0; j < 8; ++j) { const int n = (lane >> 3) + 8 * j; const LAS float* sp = scr + (8 * c) * 65 + n;
        u32x4 o; o.x = pk2h(sp[0 * 65], sp[1 * 65]); o.y = pk2h(sp[2 * 65], sp[3 * 65]); o.z = pk2h(sp[4 * 65], sp[5 * 65]); o.w = pk2h(sp[6 * 65], sp[7 * 65]);
        *(u32x4*)(WT + (size_t)(n0 + n) * K + k0 + 8 * c) = o; }
    asm volatile("s_waitcnt lgkmcnt(0)" ::: "memory");
}

__device__ __forceinline__ void transpose_item_q(const float* W, int K, int N, unsigned char* WQ, LAS float* scr, int nblk, int item, int lane, float scale) {
    const int kb = item / nblk, nb = item % nblk, k0 = 128 * kb, n0 = 32 * nb;
    const int kr = lane >> 3, nq = (lane & 7) * 4;
    f32x4 v[16];
#pragma unroll
    for (int i = 0; i < 16; ++i) v[i] = __builtin_nontemporal_load((const f32x4*)(W + (size_t)(k0 + 8 * i + kr) * N + n0 + nq));
#pragma unroll
    for (int i = 0; i < 16; ++i) { LAS float* d = scr + (8 * i + kr) * 33 + nq; d[0] = v[i][0] * scale; d[1] = v[i][1] * scale; d[2] = v[i][2] * scale; d[3] = v[i][3] * scale; }
    asm volatile("s_waitcnt lgkmcnt(0)" ::: "memory");
    const int c = lane & 7;
#pragma unroll
    for (int j = 0; j < 4; ++j) { const int n = (lane >> 3) + 8 * j; const LAS float* sp = scr + (16 * c) * 33 + n;
        u32x4 o; o.x = pk4q(sp[0 * 33], sp[1 * 33], sp[2 * 33], sp[3 * 33]); o.y = pk4q(sp[4 * 33], sp[5 * 33], sp[6 * 33], sp[7 * 33]);
        o.z = pk4q(sp[8 * 33], sp[9 * 33], sp[10 * 33], sp[11 * 33]); o.w = pk4q(sp[12 * 33], sp[13 * 33], sp[14 * 33], sp[15 * 33]);
        *(u32x4*)(WQ + (size_t)(n0 + n) * K + k0 + 16 * c) = o; }
    asm volatile("s_waitcnt lgkmcnt(0)" ::: "memory");
}

__device__ __forceinline__ void tq_issue(f32x4 (&v)[16], const float* W, int N, int k0, int n0, int lane) {
    const int kr = lane >> 3, nq = (lane & 7) * 4;
#pragma unroll
    for (int i = 0; i < 16; ++i) v[i] = __builtin_nontemporal_load((const f32x4*)(W + (size_t)(k0 + 8 * i + kr) * N + n0 + nq));
}
__device__ __forceinline__ void tq_finish(const f32x4 (&v)[16], unsigned char* WQ, int K, int k0, int n0, LAS float* scr, int lane, float scale) {
    const int kr = lane >> 3, nq = (lane & 7) * 4;
#pragma unroll
    for (int i = 0; i < 16; ++i) { LAS float* d = scr + (8 * i + kr) * 33 + (nq ^ (4 * ((i >> 2) & 3))); d[0] = v[i][0] * scale; d[1] = v[i][1] * scale; d[2] = v[i][2] * scale; d[3] = v[i][3] * scale; }
    asm volatile("s_waitcnt lgkmcnt(0)" ::: "memory");
    const int c = lane & 7;
#pragma unroll
    for (int j = 0; j < 4; ++j) { const int n = (lane >> 3) + 8 * j; const LAS float* sp = scr + (16 * c) * 33 + (n ^ (4 * ((c >> 1) & 3)));
        u32x4 o; o.x = pk4q(sp[0 * 33], sp[1 * 33], sp[2 * 33], sp[3 * 33]); o.y = pk4q(sp[4 * 33], sp[5 * 33], sp[6 * 33], sp[7 * 33]);
        o.z = pk4q(sp[8 * 33], sp[9 * 33], sp[10 * 33], sp[11 * 33]); o.w = pk4q(sp[12 * 33], sp[13 * 33], sp[14 * 33], sp[15 * 33]);
        asm volatile("global_store_dwordx4 %0, %1, off sc1 nt\n\ts_nop 1" :: "v"(WQ + (size_t)(n0 + n) * K + k0 + 16 * c), "v"(o) : "memory"); }
    asm volatile("s_waitcnt lgkmcnt(0)" ::: "memory");
}
__device__ __forceinline__ void tq_run16(const float* W, unsigned char* WQ, int K, int N, int n0, LAS float* scr, int lane, float scale) {
    f32x4 va[16], vb[16];
    tq_issue(va, W, N, 0, n0, lane);
#pragma unroll 1
    for (int j = 0; j < 16; j += 2) {
        tq_issue(vb, W, N, 128 * (j + 1), n0, lane);
        tq_finish(va, WQ, K, 128 * j, n0, scr, lane, scale);
        if (j + 2 < 16) tq_issue(va, W, N, 128 * (j + 2), n0, lane);
        tq_finish(vb, WQ, K, 128 * (j + 1), n0, scr, lane, scale);
    }
}

constexpr size_t MiB = 1u << 20;
constexpr size_t WS_CTL = 0, CTL_ZERO_BYTES = 1 * MiB;
constexpr int CW_BAR = 4096;
constexpr int CW_TQ = 8192, CW_GQ = 8256, CW_RDY0 = 8320  , CW_TMO2 = 10432;
constexpr size_t WS_ADAP = 1 * MiB;
constexpr size_t WS_ADA = 2 * MiB;
constexpr size_t WS_TOPI = 3 * MiB;
constexpr size_t WS_GATE = 4 * MiB;
constexpr size_t WS_LISTS = 5 * MiB;
constexpr size_t WS_COUNTS = 6 * MiB;
constexpr size_t WS_SLOT = 7 * MiB;
constexpr size_t WS_SEL = 8 * MiB;
constexpr size_t WS_H1H = 16 * MiB;
constexpr size_t WS_PROJ = 80 * MiB;
constexpr size_t WS_SCORES = 260 * MiB;
constexpr size_t WS_MERGEDH = 388 * MiB;
constexpr size_t WS_MIX = 452 * MiB;
constexpr size_t WS_X1 = 516 * MiB;
constexpr size_t WS_H2 = 580 * MiB;
constexpr size_t WS_H2H = 644 * MiB;
constexpr size_t WS_WTIN = 676 * MiB;
constexpr size_t WS_WTOUT = 700 * MiB;
constexpr size_t WS_WTGU = 708 * MiB;
constexpr size_t WS_WTDN = 1220 * MiB;
constexpr size_t WS_XG = 1476 * MiB;
constexpr size_t WS_ACTH = 1636 * MiB;
constexpr size_t WS_YROWS = 1796 * MiB;
constexpr size_t WS_QH = 2116 * MiB;
constexpr size_t WS_KH = 2132 * MiB;
constexpr size_t WS_VH = 2136 * MiB;
constexpr size_t WS_QIH = 2140 * MiB;
constexpr size_t WS_KIH = 2156 * MiB;
constexpr size_t WS_WI = 2157 * MiB;
constexpr size_t WS_MASK = 2158 * MiB;
constexpr size_t WS_OPART = 2162 * MiB;
constexpr size_t WS_OSTAT = 2194 * MiB;
constexpr size_t WS_END = 2196 * MiB;
#define DINP 5888
#define PMAX 40960

constexpr int LDS_BYTES = 147456;
constexpr int MISC_OFF = 139264;

struct Args { const void* in[20]; float* out; unsigned char* ws; int ph_lo, ph_hi; };

__device__ __forceinline__ void rope_cs(int pos, float invf, float& c, float& s) {
    const float ang = (float)pos * invf;
    const double rev = (double)ang * 0.15915494309189535;
    const double fr = rev - floor(rev);
    const float f = (float)fr;
    s = __builtin_amdgcn_sinf(f);
    c = __builtin_amdgcn_cosf(f);
}
__device__ __forceinline__ float bsum(float v, float* red) {
    for (int o = 32; o >= 1; o >>= 1) v += __shfl_xor(v, o);
    __syncthreads();
    if ((threadIdx.x & 63) == 0) red[threadIdx.x >> 6] = v;
    __syncthreads();
    return ((red[0] + red[1]) + (red[2] + red[3])) + ((red[4] + red[5]) + (red[6] + red[7]));
}
__device__ __forceinline__ float bmax(float v, float* red) {
    for (int o = 32; o >= 1; o >>= 1) v = fmaxf(v, __shfl_xor(v, o));
    __syncthreads();
    if ((threadIdx.x & 63) == 0) red[threadIdx.x >> 6] = v;
    __syncthreads();
    return fmaxf(fmaxf(fmaxf(red[0], red[1]), fmaxf(red[2], red[3])), fmaxf(fmaxf(red[4], red[5]), fmaxf(red[6], red[7])));
}

__device__ __forceinline__ void nb_ada_part(const float* c, const float* w, float* part, int vb, unsigned char* lds) {
    float* sc = (float*)lds;
    const int jb = vb / ADA_KC, kc = vb % ADA_KC, k0 = kc * (DM / ADA_KC);
    { const int b = threadIdx.x >> 8, k = threadIdx.x & 255; const float v = c[b * DM + k0 + k]; sc[b * 256 + k] = v / (1.0f + expf(-v)); }
    __syncthreads();
    const int j = jb * NT + threadIdx.x;
    float a0 = 0.f, a1 = 0.f;
    for (int k = 0; k < DM / ADA_KC; ++k) { const float wv = w[(size_t)(k0 + k) * (6 * DM) + j]; a0 += sc[k] * wv; a1 += sc[256 + k] * wv; }
    part[((size_t)kc * 2 + 0) * (6 * DM) + j] = a0; part[((size_t)kc * 2 + 1) * (6 * DM) + j] = a1;
    __syncthreads();
}

__device__ __forceinline__ void nb_modnorm(const float* x, const float* g, const float* ada, int sh_off, int sc_off, f16_t* out, int t, unsigned char* lds) {
    float* red = (float*)lds;
    const int bb = t / SEQ; const float* xr = x + (size_t)t * DM;
    float v[4]; float ss = 0.f;
#pragma unroll
    for (int i = 0; i < 4; ++i) { v[i] = xr[threadIdx.x + i * NT]; ss += v[i] * v[i]; }
    ss = bsum(ss, red);
    const float rstd = rsqrtf(ss * (1.0f / DM) + 1e-6f);
#pragma unroll
    for (int i = 0; i < 4; ++i) { const int col = threadIdx.x + i * NT;
        const float hv = v[i] * rstd * g[col] * (1.0f + ada[bb * 6 * DM + sc_off + col]) + ada[bb * 6 * DM + sh_off + col];
        out[(size_t)t * DM + col] = __builtin_bit_cast(unsigned short, (_Float16)hv); }
    __syncthreads();
}

template <int MODE>
__device__ __forceinline__ void nb_sgemm(const float* A, const float* B, const float* bias, float* C, int M, int N, int K, int lda, int ldb, int ldc,
                                         const int* lists, int rowbase, int m0, int n0, unsigned char* lds) {
    float (*As)[132] = (float (*)[132])lds;
    float (*Bs)[68] = (float (*)[68])(lds + 16 * 132 * 4);
    const int tid = threadIdx.x, tx = tid & 15, ty = tid >> 4;
    const int ar = tid >> 2, ak = (tid & 3) * 4;
    const int bk = (tid >> 4) & 15, bn = (tid & 15) * 4;
    const float* arow = nullptr;
    if (m0 + ar < M) {
        if (MODE == 0) arow = A + (size_t)(m0 + ar) * lda;
        else if (MODE == 1) arow = A + (size_t)(lists[m0 + ar] >> 2) * lda;
        else arow = A + (size_t)(rowbase + m0 + ar) * lda;
    }
    const bool bok = (tid < 256) && ((n0 + bn) < N);
    float acc[4][4];
#pragma unroll
    for (int i = 0; i < 4; ++i)
#pragma unroll
        for (int j = 0; j < 4; ++j) acc[i][j] = 0.f;
    for (int k0 = 0; k0 < K; k0 += 16) {
        float4 av = make_float4(0.f, 0.f, 0.f, 0.f), bv = make_float4(0.f, 0.f, 0.f, 0.f);
        if (arow) av = *(const float4*)(arow + k0 + ak);
        if (bok) bv = *(const float4*)(B + (size_t)(k0 + bk) * ldb + n0 + bn);
        __syncthreads();
        As[ak + 0][ar] = av.x; As[ak + 1][ar] = av.y; As[ak + 2][ar] = av.z; As[ak + 3][ar] = av.w;
        if (tid < 256) *(float4*)&Bs[bk][bn] = bv;
        __syncthreads();
#pragma unroll
        for (int kk = 0; kk < 16; ++kk) {
            const float4 a4 = *(const float4*)&As[kk][ty * 4];
            const float4 b4 = *(const float4*)&Bs[kk][tx * 4];
            const float a[4] = {a4.x, a4.y, a4.z, a4.w}, b[4] = {b4.x, b4.y, b4.z, b4.w};
#pragma unroll
            for (int i = 0; i < 4; ++i)
#pragma unroll
                for (int j = 0; j < 4; ++j) acc[i][j] += a[i] * b[j];
        }
    }
#pragma unroll
    for (int i = 0; i < 4; ++i) { const int m = m0 + ty * 4 + i;
        if (m < M) { const size_t crow = (MODE == 0) ? (size_t)m : (size_t)(rowbase + m);
#pragma unroll
            for (int j = 0; j < 4; ++j) { const int n = n0 + tx * 4 + j; if (n < N) C[crow * ldc + n] = acc[i][j] + (bias ? bias[n] : 0.f); } } }
    __syncthreads();
}

__device__ __forceinline__ void nb_rope_conv(float* proj, const int* positions, const float* cw, const float* g, f16_t* merged, f16_t* qh, f16_t* kh, f16_t* vh, f16_t* qih, f16_t* kih, float* wi, int t, unsigned char* lds) {
    float* red = (float*)lds;
    const int pos = positions[t]; float* pr = proj + (size_t)t * DIN;
    for (int i = threadIdx.x; i < (NH + NKV) * 16; i += NT) { const int h = i >> 4, j = i & 15;
        float* p = (h < NH) ? (pr + O_Q + h * HD) : (pr + O_K + (h - NH) * HD);
        float c, s; rope_cs(pos, c_invf16[j], c, s);
        const float x1 = p[j], x2 = p[j + 16]; p[j] = x1 * c - x2 * s; p[j + 16] = x2 * c + x1 * s; }
    for (int i = threadIdx.x; i < (IH + 1) * 8; i += NT) { const int h = i >> 3, j = i & 7;
        float* p = (h < IH) ? (pr + O_QI + h * IDIM) : (pr + O_KI);
        float c, s; rope_cs(pos, c_invf16[2 * j], c, s);
        const float x1 = p[j], x2 = p[j + 8]; p[j] = x1 * c - x2 * s; p[j + 8] = x2 * c + x1 * s; }
    __syncthreads();
    for (int i = threadIdx.x; i < 1024; i += NT) { qh[(size_t)t * 1024 + i] = __builtin_bit_cast(unsigned short, (_Float16)pr[O_Q + i]); qih[(size_t)t * 1024 + i] = __builtin_bit_cast(unsigned short, (_Float16)pr[O_QI + i]); }
    if (threadIdx.x < 256) { kh[(size_t)t * 256 + threadIdx.x] = __builtin_bit_cast(unsigned short, (_Float16)pr[O_K + threadIdx.x]); vh[(size_t)t * 256 + threadIdx.x] = __builtin_bit_cast(unsigned short, (_Float16)pr[O_V + threadIdx.x]); }
    if (threadIdx.x < 64) kih[(size_t)t * 64 + threadIdx.x] = __builtin_bit_cast(unsigned short, (_Float16)pr[O_KI + threadIdx.x]);
    if (threadIdx.x < 16) wi[(size_t)t * 16 + threadIdx.x] = pr[O_WI + threadIdx.x];
    const int tl = t % SEQ;
    float y[2]; float ss = 0.f;
#pragma unroll
    for (int i = 0; i < 2; ++i) { const int c = threadIdx.x + i * NT;
        const float* p0 = proj + (size_t)t * DIN;
        float acc = cw[2 * DCONV + c] * (p0[O_CG + c] * p0[O_U + c]);
        if (tl >= 1) { const float* p1 = p0 - DIN; acc += cw[1 * DCONV + c] * (p1[O_CG + c] * p1[O_U + c]); }
        if (tl >= 2) { const float* p2 = p0 - 2 * DIN; acc += cw[0 * DCONV + c] * (p2[O_CG + c] * p2[O_U + c]); }
        y[i] = p0[O_BG + c] * acc; ss += y[i] * y[i]; }
    ss = bsum(ss, red);
    const float rstd = rsqrtf(ss * (1.0f / DCONV) + 1e-6f);
#pragma unroll
    for (int i = 0; i < 2; ++i) { const int c = threadIdx.x + i * NT; merged[(size_t)t * DM + c] = __builtin_bit_cast(unsigned short, (_Float16)(y[i] * rstd * g[c])); }
    __syncthreads();
}

__device__ __forceinline__ void nb_scores(const float* proj, float* scores, int t, unsigned char* lds) {
    float* qi = (float*)lds; float* w = qi + IH * IDIM;
    const int tl = t % SEQ, t0 = t - tl;
    for (int i = threadIdx.x; i < IH * IDIM; i += NT) qi[i] = proj[(size_t)t * DIN + O_QI + i];
    if (threadIdx.x < IH) w[threadIdx.x] = proj[(size_t)t * DIN + O_WI + threadIdx.x];
    __syncthreads();
    for (int s = threadIdx.x; s <= tl; s += NT) {
        const float* kp = proj + (size_t)(t0 + s) * DIN + O_KI;
        float kr[IDIM];
#pragma unroll
        for (int d = 0; d < IDIM; ++d) kr[d] = kp[d];
        float acc = 0.f;
        for (int h = 0; h < IH; ++h) { float dot = 0.f;
#pragma unroll
            for (int d = 0; d < IDIM; ++d) dot += qi[h * IDIM + d] * kr[d];
            acc += w[h] * fmaxf(dot, 0.f); }
        scores[(size_t)t * SEQ + s] = acc;
    }
    __syncthreads();
}

__device__ __forceinline__ void nb_topk(const float* scores, int* sel, int t, unsigned char* lds) {
    unsigned long long* key = (unsigned long long*)lds;
    const int tl = t % SEQ;
    for (int i = threadIdx.x; i < SEQ; i += NT) {
        unsigned long long kv = 0ull;
        if (i <= tl) { unsigned u = __float_as_uint(scores[(size_t)t * SEQ + i]); u = (u & 0x80000000u) ? ~u : (u | 0x80000000u);
            kv = ((unsigned long long)u << 32) | (unsigned)(0xFFFFFFFFu - (unsigned)i); }
        key[i] = kv; }
    __syncthreads();
    for (int k = 2; k <= SEQ; k <<= 1)
        for (int j = k >> 1; j > 0; j >>= 1) {
            for (int i = threadIdx.x; i < SEQ; i += NT) { const int ixj = i ^ j;
                if (ixj > i) { const unsigned long long a = key[i], b = key[ixj]; const bool desc = ((i & k) == 0);
                    if (desc ? (a < b) : (a > b)) { key[i] = b; key[ixj] = a; } } }
            __syncthreads();
        }
    for (int i = threadIdx.x; i < TOPK; i += NT) { const unsigned long long kv = key[i];
        sel[(size_t)t * TOPK + i] = (kv == 0ull) ? -1 : (int)(0xFFFFFFFFu - (unsigned)(kv & 0xFFFFFFFFull)); }
    __syncthreads();
}

__device__ __forceinline__ void nb_attn(const float* proj, const int* sel, const float* g, f16_t* merged, int t, unsigned char* lds) {
    float* red = (float*)lds; float* q = red + 8; float* p = q + NH * HD; float* y = p + TOPK; int* si = (int*)(y + NH * HD);
    const int tl = t % SEQ, t0 = t - tl, tid = threadIdx.x;
    for (int i = tid; i < NH * HD; i += NT) q[i] = proj[(size_t)t * DIN + O_Q + i];
    if (tid < TOPK) { const int s = sel[(size_t)t * TOPK + tid]; si[tid] = (s >= 0 && s <= tl) ? s : -1; }
    __syncthreads();
    const float scale = 0.08838834764831845f;
    for (int h = 0; h < NH; ++h) { const int gk = h / (NH / NKV);
        const int s = (tid < TOPK) ? si[tid] : -1; float logit = -INFINITY;
        if (s >= 0) { const float* kp = proj + (size_t)(t0 + s) * DIN + O_K + gk * HD; float d = 0.f;
            for (int i = 0; i < HD; ++i) d += q[h * HD + i] * kp[i];
            logit = d * scale; }
        const float mx = bmax(logit, red);
        const float ex = (s >= 0) ? expf(logit - mx) : 0.f;
        const float sum = bsum(ex, red);
        if (tid < TOPK) p[tid] = ex / sum;
        __syncthreads();
        if (tid < HD) { float o = 0.f;
            for (int i = 0; i < TOPK; ++i) { const int s2 = si[i]; if (s2 >= 0) o += p[i] * proj[(size_t)(t0 + s2) * DIN + O_V + gk * HD + tid]; }
            y[h * HD + tid] = o; }
        __syncthreads();
    }
    float ss = 0.f;
#pragma unroll
    for (int i = 0; i < 2; ++i) { const float v = y[tid + i * NT]; ss += v * v; }
    ss = bsum(ss, red);
    const float rstd = rsqrtf(ss * (1.0f / (NH * HD)) + 1e-6f);
#pragma unroll
    for (int i = 0; i < 2; ++i) { const int c = tid + i * NT; merged[(size_t)t * DM + DCONV + c] = __builtin_bit_cast(unsigned short, (_Float16)(y[c] * rstd * g[c])); }
    __syncthreads();
}

__device__ __forceinline__ void nb_post_mix(const float* x, const float* mix, const float* gpost, const float* gpre, const float* ada, float* x1, float* h2, f16_t* h2h, int t, unsigned char* lds) {
    float* red = (float*)lds;
    const int bb = t / SEQ; const float* ad = ada + bb * 6 * DM;
    float m[4], xv[4]; float ss = 0.f;
#pragma unroll
    for (int i = 0; i < 4; ++i) { m[i] = mix[(size_t)t * DM + threadIdx.x + i * NT]; ss += m[i] * m[i]; }
    ss = bsum(ss, red);
    const float r1 = rsqrtf(ss * (1.0f / DM) + 1e-6f);
    float s2 = 0.f;
#pragma unroll
    for (int i = 0; i < 4; ++i) { const int c = threadIdx.x + i * NT; xv[i] = x[(size_t)t * DM + c] + ad[A_GT1 + c] * (m[i] * r1 * gpost[c]); s2 += xv[i] * xv[i]; }
    s2 = bsum(s2, red);
    const float r2 = rsqrtf(s2 * (1.0f / DM) + 1e-6f);
#pragma unroll
    for (int i = 0; i < 4; ++i) { const int c = threadIdx.x + i * NT; x1[(size_t)t * DM + c] = xv[i];
        const float hv = xv[i] * r2 * gpre[c] * (1.0f + ad[A_SC2 + c]) + ad[A_SH2 + c];
        h2[(size_t)t * DM + c] = hv; h2h[(size_t)t * DM + c] = __builtin_bit_cast(unsigned short, (_Float16)hv); }
    __syncthreads();
}

__device__ __forceinline__ void nb_router(const float* h2, const float* wr, const float* br, int* topi, float* gate, int vb, unsigned char* lds) {
    float (*lg)[NE] = (float (*)[NE])lds;
    const int tl = threadIdx.x >> 5, e = threadIdx.x & 31, t = vb * 16 + tl;
    const float* hr = h2 + (size_t)t * DM; float acc = 0.f;
    for (int k = 0; k < DM; ++k) acc += hr[k] * wr[k * NE + e];
    lg[tl][e] = acc + br[e];
    __syncthreads();
    if (e == 0) { float v[NE];
#pragma unroll
        for (int i = 0; i < NE; ++i) v[i] = lg[tl][i];
        int idx[TK]; float val[TK];
#pragma unroll
        for (int k = 0; k < TK; ++k) { float best = -INFINITY; int bi = 0;
#pragma unroll
            for (int i = 0; i < NE; ++i) { const bool take = v[i] > best; best = take ? v[i] : best; bi = take ? i : bi; }
            idx[k] = bi; val[k] = best;
#pragma unroll
            for (int i = 0; i < NE; ++i) v[i] = (i == bi) ? -INFINITY : v[i]; }
        float s = 0.f, ex[TK];
#pragma unroll
        for (int k = 0; k < TK; ++k) { ex[k] = expf(val[k] - val[0]); s += ex[k]; }
#pragma unroll
        for (int k = 0; k < TK; ++k) { topi[t * TK + k] = idx[k]; gate[t * TK + k] = ex[k] / s; } }
    __syncthreads();
}

__device__ __forceinline__ void nb_lists(const int* topi, int* lists, int* counts, int* slotpos, int e) {
    const int lane = threadIdx.x & 63; int base = 0;
    for (int f0 = 0; f0 < NROWS; f0 += 64) { const int f = f0 + lane; const bool m = topi[f] == e;
        const unsigned long long mask = __ballot(m);
        const int pos = base + __popcll(mask & ((1ull << lane) - 1ull));
        if (m) { lists[(size_t)e * NTOK + pos] = f; slotpos[f] = pos; }
        base += __popcll(mask); }
    if (lane == 0) counts[e] = base;
}

__device__ __forceinline__ void nb_final(const float* x1, const float* yrows, const int* topi, const float* gate, const int* counts, const int* slotpos, const float* gpost, const float* ada,
                                         float* out, int t, unsigned char* lds) {
    float* red = (float*)lds; int* row = (int*)(red + 8); float* gw = red + 16;
    const int bb = t / SEQ; const float* ad = ada + bb * 6 * DM;
    if (threadIdx.x < TK) { const int f = t * TK + threadIdx.x, e = topi[f]; int st = 0; for (int i = 0; i < e; ++i) st += ((counts[i] + 255) >> 8) << 8;
        row[threadIdx.x] = st + slotpos[f]; gw[threadIdx.x] = gate[f]; }
    __syncthreads();
    float y[4]; float ss = 0.f;
#pragma unroll
    for (int i = 0; i < 4; ++i) { const int c = threadIdx.x + i * NT; float a = 0.f;
#pragma unroll
        for (int k = 0; k < TK; ++k) a += gw[k] * yrows[(size_t)row[k] * DM + c];
        y[i] = a; ss += a * a; }
    ss = bsum(ss, red);
    const float r = rsqrtf(ss * (1.0f / DM) + 1e-6f);
#pragma unroll
    for (int i = 0; i < 4; ++i) { const int c = threadIdx.x + i * NT; out[(size_t)t * DM + c] = x1[(size_t)t * DM + c] + ad[A_GT2 + c] * (y[i] * r * gpost[c]); }
    __syncthreads();
}


typedef float f32x16 __attribute__((ext_vector_type(16)));
__device__ __forceinline__ void ph_scores_pair(const f16_t* qih, const f16_t* kih, const float* wi, float* scores, int t0, int lane) {
    const int r = lane & 31, hi = lane >> 5, tl0 = t0 % SEQ, tb = t0 - tl0;
    const int arow_q = t0 + ((r >> 2) & 1), arow_h = (r & 3) + 4 * (r >> 3);
    f16x8 aq[4];
#pragma unroll
    for (int kk = 0; kk < 4; ++kk) aq[kk] = *(const f16x8*)(qih + (size_t)arow_q * 1024 + arow_h * 64 + kk * 16 + 8 * hi);
    float w[16];
#pragma unroll
    for (int i = 0; i < 4; ++i) { const f32x4 wv = *(const f32x4*)(wi + (size_t)(t0 + hi) * 16 + 4 * i); w[4 * i] = wv[0]; w[4 * i + 1] = wv[1]; w[4 * i + 2] = wv[2]; w[4 * i + 3] = wv[3]; }
    const int ntile = ((tl0 + 1) >> 5) + 1;
    float* orow = scores + (size_t)(t0 + hi) * SEQ + r;
    const f16_t* kp = kih + (size_t)(tb + r) * 64 + 8 * hi;
    f16x8 bk[4][4];
#define SC_LOAD(slot, kt_) do { const int kc_ = ((kt_) < ntile) ? (kt_) : (ntile - 1); _Pragma("unroll") for (int kk = 0; kk < 4; ++kk) bk[slot][kk] = *(const f16x8*)(kp + (size_t)kc_ * 32 * 64 + kk * 16); } while (0)
#define SC_TILE(slot, kt_) do { if ((kt_) < ntile) { f32x16 acc = {0.f, 0.f, 0.f, 0.f, 0.f, 0.f, 0.f, 0.f, 0.f, 0.f, 0.f, 0.f, 0.f, 0.f, 0.f, 0.f}; \
        _Pragma("unroll") for (int kk = 0; kk < 4; ++kk) acc = __builtin_amdgcn_mfma_f32_32x32x16_f16(aq[kk], bk[slot][kk], acc, 0, 0, 0); \
        float sc = 0.f; _Pragma("unroll") for (int i = 0; i < 16; ++i) sc += w[i] * fmaxf(acc[i], 0.f); \
        orow[(kt_) * 32] = sc; } } while (0)
    SC_LOAD(0, 0); SC_LOAD(1, 1); SC_LOAD(2, 2);
    for (int kt = 0; kt < ntile; kt += 4) {
        SC_LOAD(3, kt + 3); SC_TILE(0, kt);
        SC_LOAD(0, kt + 4); SC_TILE(1, kt + 1);
        SC_LOAD(1, kt + 5); SC_TILE(2, kt + 2);
        SC_LOAD(2, kt + 6); SC_TILE(3, kt + 3);
    }
#undef SC_LOAD
#undef SC_TILE
}


__device__ __forceinline__ void ph_scores_block(const f16_t* qih, const f16_t* kih, const float* wi, float* scores, int tq0, LAS unsigned char* lds) {
    const int tid = threadIdx.x, lane = tid & 63, wv = __builtin_amdgcn_readfirstlane(tid >> 6), r = lane & 31, hi = lane >> 5;
    const int t0 = tq0 + 2 * wv, tl0 = t0 % SEQ, tb = t0 - tl0, tlmax = (tq0 % SEQ) + 15;
    const int arow_q = t0 + ((r >> 2) & 1), arow_h = (r & 3) + 4 * (r >> 3);
    f16x8 aq[4];
#pragma unroll
    for (int kk = 0; kk < 4; ++kk) aq[kk] = *(const f16x8*)(qih + (size_t)arow_q * 1024 + arow_h * 64 + kk * 16 + 8 * hi);
    float w[16];
#pragma unroll
    for (int i = 0; i < 4; ++i) { const f32x4 wvv = *(const f32x4*)(wi + (size_t)(t0 + hi) * 16 + 4 * i); w[4 * i] = wvv[0]; w[4 * i + 1] = wvv[1]; w[4 * i + 2] = wvv[2]; w[4 * i + 3] = wvv[3]; }
    const int nchunk = (tlmax >> 8) + 1;
    float* orow = scores + (size_t)(t0 + hi) * SEQ + r;
    const u32x4* gsrc = (const u32x4*)(kih + (size_t)tb * 64) + tid;
    u32x4 st[4];
#define SCB_WRITE(buf) do { _Pragma("unroll") for (int i = 0; i < 4; ++i) { const int q = tid + 512 * i; *(LAS u32x4*)(lds + (buf) * 36864 + (q >> 3) * 144 + (q & 7) * 16) = st[i]; } } while (0)
#pragma unroll
    for (int i = 0; i < 4; ++i) st[i] = gsrc[512 * i];
    SCB_WRITE(0);
    __syncthreads();
    for (int c = 0; c < nchunk; ++c) {
        if (c + 1 < nchunk) {
#pragma unroll
            for (int i = 0; i < 4; ++i) st[i] = gsrc[(size_t)(c + 1) * 2048 + 512 * i]; }
        const LAS unsigned char* kb = lds + (c & 1) * 36864 + r * 144 + hi * 16;
#pragma unroll
        for (int kt = 0; kt < 8; ++kt) { const int s0 = c * 256 + kt * 32;
            if (s0 <= tl0 + 1) {
                f32x16 acc = {0.f, 0.f, 0.f, 0.f, 0.f, 0.f, 0.f, 0.f, 0.f, 0.f, 0.f, 0.f, 0.f, 0.f, 0.f, 0.f};
#pragma unroll
                for (int kk = 0; kk < 4; ++kk) acc = __builtin_amdgcn_mfma_f32_32x32x16_f16(aq[kk], *(const LAS f16x8*)(kb + kt * 32 * 144 + kk * 32), acc, 0, 0, 0);
                float sc = 0.f;
#pragma unroll
                for (int i = 0; i < 16; ++i) sc += w[i] * fmaxf(acc[i], 0.f);
                orow[s0] = sc; } }
        if (c + 1 < nchunk) SCB_WRITE((c + 1) & 1);
        __syncthreads();
    }
#undef SCB_WRITE
}

__device__ __forceinline__ void ph_select_row(const float* scores, unsigned long long* mask, int t, int lane) {
    const int tl = t % SEQ, n = tl + 1, nj = (n + 63) >> 6;
    const float* srow = scores + (size_t)t * SEQ;
    unsigned key[64];
#pragma unroll
    for (int g16 = 0; g16 < 4; ++g16) {
        if (g16 * 16 < nj) { float sv[16];
#pragma unroll
            for (int jj = 0; jj < 16; ++jj) { const int idx = (g16 * 16 + jj) * 64 + lane; sv[jj] = srow[idx <= tl ? idx : tl]; }
#pragma unroll
            for (int jj = 0; jj < 16; ++jj) { const int idx = (g16 * 16 + jj) * 64 + lane; unsigned u = __float_as_uint(sv[jj]); u = (u & 0x80000000u) ? ~u : (u | 0x80000000u);
                key[g16 * 16 + jj] = (idx <= tl) ? u : 0u; } }
        else {
#pragma unroll
            for (int jj = 0; jj < 16; ++jj) key[g16 * 16 + jj] = 0u; } }
    unsigned long long* mrow = mask + (size_t)t * 64;
    if (n <= TOPK) {
#pragma unroll
        for (int j = 0; j < 64; ++j) { const unsigned long long m = (j < nj) ? __ballot(j * 64 + lane <= tl) : 0ull; if (lane == 0) mrow[j] = m; }
        return;
    }
    unsigned T = 0u; bool exact = false;
    for (int bit = 31; bit >= 0; --bit) { const unsigned cand = T | (1u << bit); int cl = 0;
#pragma unroll
        for (int g16 = 0; g16 < 4; ++g16) if (g16 * 16 < nj) {
#pragma unroll
            for (int jj = 0; jj < 16; ++jj) cl += (key[g16 * 16 + jj] >= cand) ? 1 : 0; }
        cl += __builtin_amdgcn_update_dpp(0, cl, 0xb1, 0xf, 0xf, false);
        cl += __builtin_amdgcn_update_dpp(0, cl, 0x4e, 0xf, 0xf, false);
        cl += __builtin_amdgcn_update_dpp(0, cl, 0x124, 0xf, 0xf, false);
        cl += __builtin_amdgcn_update_dpp(0, cl, 0x128, 0xf, 0xf, false);
        cl += __builtin_amdgcn_update_dpp(0, cl, 0x142, 0xa, 0xf, false);
        cl += __builtin_amdgcn_update_dpp(0, cl, 0x143, 0xc, 0xf, false);
        const int cnt = __builtin_amdgcn_readlane(cl, 63);
        if (cnt >= TOPK) T = cand;
        if (cnt == TOPK) { exact = true; break; } }
    int cgt = 0;
    if (exact) { cgt = TOPK; if (T > 0u) T -= 1u; }
    else {
#pragma unroll
        for (int j = 0; j < 64; ++j) if (j < nj) cgt += __popcll(__ballot(key[j] > T)); }
    int need = TOPK - cgt;
#pragma unroll
    for (int j = 0; j < 64; ++j) { unsigned long long m = 0ull;
        if (j < nj) { unsigned long long eq = __ballot(key[j] == T); const unsigned long long gt = __ballot(key[j] > T);
            int c = __popcll(eq);
            while (c > need) { eq &= ~(1ull << (63 - __clzll((long long)eq))); --c; }
            need -= c; m = gt | eq;
            }
        if (lane == 0) mrow[j] = m; }
}


namespace att {
constexpr int D = 128, QS = 1024, KVS = 256;
constexpr float SCALE = 0.08838834764831845f, THR = 8.f;
constexpr int NW = 8, QBLK = 32, KVBLK = 64, QB = NW * QBLK;
constexpr int SHM_V = KVBLK * D * 2, SHM_K = KVBLK * D * 2;
constexpr int ATT_LDS_BYTES = 2 * SHM_V + 2 * SHM_K + NW * 64 * 4;
typedef short bf16x8 __attribute__((ext_vector_type(8)));
typedef short s16x4 __attribute__((ext_vector_type(4)));
#define ATT_MFMA(a, b, c) __builtin_amdgcn_mfma_f32_32x32x16_f16(__builtin_bit_cast(f16x8, a), __builtin_bit_cast(f16x8, b), c, 0, 0, 0)
#define KSWZ(row, colB) ((row) * 256 + ((colB) ^ (((row) & 7) << 4)))
#define SBAR() __builtin_amdgcn_sched_barrier(0)
__device__ __forceinline__ int v_st(int k, int c) { const int kk = (k & ~0xC) | ((k & 4) << 1) | ((k & 8) >> 1); return ((kk >> 3) * 4 + (c >> 5)) * 512 + ((kk & 7) * 32 + (c & 31)) * 2; }
__device__ __forceinline__ int v_rd_base(int lane) { return ((lane & 3) << 3) | (((lane >> 2) & 3) << 6) | (((lane >> 4) & 1) << 5) | (((lane >> 5) & 1) << 8); }
constexpr int v_rd_off(int d0, int ks, int half) { return d0 * 512 + ks * 4096 + half * 2048; }
__device__ __forceinline__ int crow(int r, int hi) { return (r & 3) + 8 * (r >> 2) + 4 * hi; }
__device__ __forceinline__ unsigned cvtpk(float lo, float hi) { unsigned r; asm volatile("v_cvt_pk_f16_f32 %0, %1, %2" : "=v"(r) : "v"(lo), "v"(hi)); return r; }
__device__ __forceinline__ bf16x8 load8(const f16_t* p) { return *reinterpret_cast<const bf16x8*>(p); }
__device__ __forceinline__ void mask_bits(f32x16& p0, f32x16& p1, unsigned lo, unsigned hiw, int hi) {
    const float NEG = -__builtin_inff();
    const unsigned l = lo >> (4 * hi), h = hiw >> (4 * hi);
#pragma unroll
    for (int r = 0; r < 16; ++r) {
        const int c = (r & 3) + 8 * (r >> 2);
        if (((l >> c) & 1u) == 0u) p0[r] = NEG;
        if (((h >> c) & 1u) == 0u) p1[r] = NEG;
    }
}
__device__ __forceinline__ void partialSM(f32x16& p0, f32x16& p1, float& m_reg, float& mn, float& alpha) {
    float pmax = p0[0]; for (int r = 1; r < 16; ++r) pmax = fmaxf(pmax, p0[r]); for (int r = 0; r < 16; ++r) pmax = fmaxf(pmax, p1[r]);
    { auto rr = __builtin_amdgcn_permlane32_swap(__float_as_uint(pmax), __float_as_uint(pmax), false, false);
      pmax = fmaxf(__uint_as_float(rr[0]), __uint_as_float(rr[1])); }
    constexpr float C2 = 1.4426950408889634f * SCALE;
    if (__builtin_expect(__all((pmax - m_reg) * SCALE <= THR), 1)) { mn = m_reg; alpha = 1.f; }
    else { mn = fmaxf(m_reg, pmax); alpha = __builtin_amdgcn_exp2f((m_reg - mn) * C2); m_reg = mn; }
    const float mnL = -mn * C2;
    for (int r = 0; r < 16; ++r) p0[r] = fmaf(p0[r], C2, mnL); for (int r = 0; r < 16; ++r) p1[r] = fmaf(p1[r], C2, mnL);
    for (int r = 0; r < 16; ++r) p0[r] = __builtin_amdgcn_exp2f(p0[r]);
}
__device__ __forceinline__ void finishSM(f32x16& p0, f32x16& p1, float alpha, float& l_reg, bf16x8& pa0, bf16x8& pa1, bf16x8& pa2, bf16x8& pa3) {
    for (int r = 0; r < 16; ++r) p1[r] = __builtin_amdgcn_exp2f(p1[r]);
    float ps = 0; for (int r = 0; r < 16; ++r) ps += p0[r]; for (int r = 0; r < 16; ++r) ps += p1[r];
    { auto rr = __builtin_amdgcn_permlane32_swap(__float_as_uint(ps), __float_as_uint(ps), false, false);
      ps = __uint_as_float(rr[0]) + __uint_as_float(rr[1]); }
    l_reg = l_reg * alpha + ps;
#define PK4(P, B_, OUT) do { unsigned a0 = cvtpk(P[B_+0], P[B_+1]), a1 = cvtpk(P[B_+2], P[B_+3]);                          \
        unsigned b0 = cvtpk(P[B_+4], P[B_+5]), b1 = cvtpk(P[B_+6], P[B_+7]);                                             \
        auto r0 = __builtin_amdgcn_permlane32_swap(a0, b0, false, false); auto r1 = __builtin_amdgcn_permlane32_swap(a1, b1, false, false); \
        u32x4 w = {r0[0], r1[0], r0[1], r1[1]}; OUT = *reinterpret_cast<bf16x8*>(&w); } while (0)
    PK4(p0, 0, pa0); PK4(p0, 8, pa1); PK4(p1, 0, pa2); PK4(p1, 8, pa3);
#undef PK4
}
template <int KB>
__device__ __forceinline__ void qkt(f32x16& p0, f32x16& p1, const char* K_lds, int r32, int hi, const bf16x8* qr) {
    p0 = f32x16{}; p1 = f32x16{};
    const char* kb[4];
#pragma unroll
    for (int dd = 0; dd < 4; ++dd) kb[dd] = K_lds + KB * SHM_K + KSWZ(r32, (dd * 16 + hi * 8) * 2);
#pragma unroll
    for (int d0 = 0; d0 < 8; ++d0) { const char* a = kb[d0 & 3] + (d0 >> 2) * 128;
        bf16x8 b0 = *reinterpret_cast<const bf16x8*>(a);
        bf16x8 b1 = *reinterpret_cast<const bf16x8*>(a + 32 * 256);
        p0 = ATT_MFMA(b0, qr[d0], p0);
        p1 = ATT_MFMA(b1, qr[d0], p1); }
}
template <int VB>
__device__ __forceinline__ void pv_tile(f32x16* o, int vb0, bf16x8 pa0, bf16x8 pa1, bf16x8 pa2, bf16x8 pa3) {
#define TRRD(dst, off) asm volatile("ds_read_b64_tr_b16 %0, %1 offset:%2" : "=&v"(dst) : "v"(vb0), "i"(off) : "memory")
#define PV_D0(d0) do { s16x4 l0, l1, l2, l3, h0, h1, h2, h3; constexpr int b_ = VB * SHM_V + v_rd_off(d0, 0, 0); \
        TRRD(l0, b_); TRRD(h0, b_ + 2048); TRRD(l1, b_ + 4096); TRRD(h1, b_ + 6144); TRRD(l2, b_ + 8192); TRRD(h2, b_ + 10240); TRRD(l3, b_ + 12288); TRRD(h3, b_ + 14336); \
        asm volatile("s_waitcnt lgkmcnt(0)" ::: "memory"); SBAR();   \
        o[d0] = ATT_MFMA(pa0, ((bf16x8){l0[0], l0[1], l0[2], l0[3], h0[0], h0[1], h0[2], h0[3]}), o[d0]);   \
        o[d0] = ATT_MFMA(pa1, ((bf16x8){l1[0], l1[1], l1[2], l1[3], h1[0], h1[1], h1[2], h1[3]}), o[d0]);   \
        o[d0] = ATT_MFMA(pa2, ((bf16x8){l2[0], l2[1], l2[2], l2[3], h2[0], h2[1], h2[2], h2[3]}), o[d0]);   \
        o[d0] = ATT_MFMA(pa3, ((bf16x8){l3[0], l3[1], l3[2], l3[3], h3[0], h3[1], h3[2], h3[3]}), o[d0]); } while (0)
    PV_D0(0); PV_D0(1); PV_D0(2); PV_D0(3);
#undef PV_D0
#undef TRRD
}

struct BlockRef { const f16_t* Q; const f16_t* K; const f16_t* V; const unsigned long long* M; f16_t* O; float* ST; int j_lo, j_hi; };
struct Seam { bf16x8 qr[8]; bf16x8 st_v0, st_v1, st_k0, st_k1; };
#define ROWOFF(k0, rr) ((unsigned)((((k0) + (rr)) * KVS + sc) * 2))
#define LD8(base, off) (*reinterpret_cast<const bf16x8*>((const char*)(base) + (off)))
#define VMW() asm volatile("s_waitcnt vmcnt(0)" ::: "memory")
#define VMWN(n) asm volatile("s_waitcnt vmcnt(%0)" :: "i"(n) : "memory")
#define SLOAD_H(Kp, Vp, k0) do { S.st_v0 = LD8(Vp, ROWOFF(k0, sr)); S.st_v1 = LD8(Vp, ROWOFF(k0, 32 + sr));              \
                         S.st_k0 = LD8(Kp, ROWOFF(k0, sr)); S.st_k1 = LD8(Kp, ROWOFF(k0, 32 + sr)); } while (0)
#define SWRITE_HK(bf) do { *(bf16x8*)(K_lds + (bf) * SHM_K + kws) = S.st_k0; *(bf16x8*)(K_lds + (bf) * SHM_K + kws + 32 * 256) = S.st_k1; } while (0)
#define SWRITE_HV(bf) do { *(bf16x8*)(V_lds + (bf) * SHM_V + vst0) = S.st_v0; *(bf16x8*)(V_lds + (bf) * SHM_V + vst1) = S.st_v1; } while (0)
#define SWRITE_H(bf) do { SWRITE_HV(bf); SWRITE_HK(bf); } while (0)
__device__ __forceinline__ void attn_block(const BlockRef& cur, char* lds) {
    const int tid = threadIdx.x, wid = __builtin_amdgcn_readfirstlane(tid >> 6), lane = tid & 63, r32 = lane & 31, hi = lane >> 5;
    const int j_lo = cur.j_lo, NTL = cur.j_hi - cur.j_lo;
    char* V_lds = lds; char* K_lds = lds + 2 * SHM_V;
    float* ws = (float*)(lds + 2 * SHM_V + 2 * SHM_K) + wid * 64; float* li_l = ws, * al_l = ws + 32;
    float m_reg = -1e30f, l_reg = 0; f32x16 o[4] = {};
    const int sr = tid >> 4, sc = (tid & 15) * 8, vst0 = v_st(sr, sc), vst1 = v_st(32 + sr, sc), kws = KSWZ(sr, sc * 2);
    const int vb0 = (int)(uintptr_t)V_lds + v_rd_base(lane);
    const f16_t* Kh = cur.K; const f16_t* Vh = cur.V;
    Seam S;
#define MROW(t_) (*(const unsigned long long*)((const char*)cur.M + (unsigned)((((wid * QBLK + r32) * 64) + j_lo + (t_)) * 8)))
#define RESC(a) do { if (__any((a) < 1.f)) { if (hi == 0) al_l[r32] = (a); asm volatile("s_waitcnt lgkmcnt(0)" ::: "memory");              \
                     for (int d_ = 0; d_ < 4; ++d_) for (int r = 0; r < 16; ++r) o[d_][r] *= al_l[crow(r, hi)]; } } while (0)
#define KBASE(t) ((j_lo + (t)) * KVBLK)
#define MASKW(P0_, P1_, mw_) mask_bits(P0_, P1_, (unsigned)(mw_), (unsigned)((mw_) >> 32), hi)
#pragma unroll
    for (int d0 = 0; d0 < 8; ++d0) S.qr[d0] = *reinterpret_cast<const bf16x8*>((const char*)cur.Q + (unsigned)(((wid * QBLK + r32) * QS + d0 * 16 + hi * 8) * 2));
    SLOAD_H(Kh, Vh, KBASE(0)); VMW(); SWRITE_H(0);
    __syncthreads();
    f32x16 p0, p1; float mn, al; bf16x8 pa0, pa1, pa2, pa3; unsigned long long mw;
#define STEP(t, CB, NBUF) do {                                                                                                \
        mw = MROW(t); SBAR();                                                                                                 \
        if ((t) + 1 < NTL) { SLOAD_H(Kh, Vh, KBASE((t) + 1)); SBAR(); }                                                       \
        qkt<CB>(p0, p1, K_lds, r32, hi, S.qr);                                                                                \
        MASKW(p0, p1, mw); partialSM(p0, p1, m_reg, mn, al); finishSM(p0, p1, al, l_reg, pa0, pa1, pa2, pa3);                 \
        RESC(al); SBAR();                                                                                                     \
        pv_tile<CB>(o, vb0, pa0, pa1, pa2, pa3);                                                                              \
        if ((t) + 1 < NTL) { VMW(); SWRITE_H(NBUF); }                                                                         \
        __syncthreads(); } while (0)
    for (int t = 0; t < NTL; t += 2) { STEP(t, 0, 1); STEP(t + 1, 1, 0); }
    if (hi == 0) { li_l[r32] = l_reg; *(float2*)(cur.ST + (size_t)(wid * QBLK + r32) * 16) = make_float2(m_reg, l_reg); }
    asm volatile("s_waitcnt lgkmcnt(0)" ::: "memory");
    float rli[16];
#pragma unroll
    for (int r = 0; r < 16; ++r) { const float lv = li_l[crow(r, hi)]; rli[r] = lv > 0.f ? __builtin_amdgcn_rcpf(lv) : 0.f; }
    f16_t* Ow = cur.O + (size_t)(wid * QBLK) * QS;
#pragma unroll
    for (int r = 0; r < 16; ++r) { const int orow = crow(r, hi);
#pragma unroll
        for (int d0 = 0; d0 < 4; ++d0) { const float v = o[d0][r] * rli[r];
            const float vn = __shfl_xor(v, 1);
            if ((r32 & 1) == 0) *(unsigned*)(Ow + (size_t)orow * QS + d0 * 32 + r32) = cvtpk(v, vn); } }
    __syncthreads();
#undef RESC
#undef KBASE
#undef MROW
#undef MASKW
#undef STEP
}
#undef ROWOFF
#undef LD8
#undef VMW
#undef VMWN
#undef SLOAD_H
#undef SWRITE_HK
#undef SWRITE_HV
#undef SWRITE_H
#undef KSWZ
#undef SBAR
}

__device__ __forceinline__ float wsum_dpp(float v) {
    int x = __float_as_int(v);
#define WS_STEP(ctrl, rmask) x = __float_as_int(__int_as_float(x) + __int_as_float(__builtin_amdgcn_update_dpp(0, x, ctrl, rmask, 0xf, false)))
    WS_STEP(0xb1, 0xf); WS_STEP(0x4e, 0xf); WS_STEP(0x124, 0xf); WS_STEP(0x128, 0xf); WS_STEP(0x142, 0xa); WS_STEP(0x143, 0xc);
#undef WS_STEP
    return __int_as_float(__builtin_amdgcn_readlane(x, 63));
}
__device__ __forceinline__ att::BlockRef att_ref(int idx, const f16_t* qh, const f16_t* kh, const f16_t* vh, const unsigned long long* maskp, f16_t* opart, float* ostat) {
    const int item = idx >> 1, which = idx & 1;
    const int bh = item >> 4, b = bh >> 3, h = bh & 7, r = item & 15, p = r >> 1, s = r & 1;
    const int qb = which ? 15 - p : p;
    const int tok0 = b * SEQ + qb * 256, g = h >> 2;
    att::BlockRef R;
    R.Q = qh + (size_t)tok0 * 1024 + h * 128;
    R.K = kh + (size_t)(b * SEQ) * 256 + g * 128;
    R.V = vh + (size_t)(b * SEQ) * 256 + g * 128;
    R.M = maskp + (size_t)tok0 * 64;
    R.O = opart + ((size_t)s * NTOK + tok0) * 1024 + h * 128;
    R.ST = ostat + (((size_t)s * NTOK + tok0) * 8 + h) * 2;
    R.j_lo = s ? 2 * (qb + 1) : 0; R.j_hi = s ? 4 * (qb + 1) : 2 * (qb + 1);
    return R;
}
__device__ __forceinline__ void ph_merge_rows4(const f16_t* opart, const float* ostat, const float* g, f16_t* merged, int t0, int tstride, int lane) {
    const int h = lane >> 3; constexpr float C2 = 1.4426950408889634f * att::SCALE;
    float gv[16];
#pragma unroll
    for (int i = 0; i < 4; ++i) { const f32x4 q = *(const f32x4*)(g + 16 * lane + 4 * i); gv[4 * i] = q[0]; gv[4 * i + 1] = q[1]; gv[4 * i + 2] = q[2]; gv[4 * i + 3] = q[3]; }
    float2 s0[4], s1[4]; f16x8 u[4][2], v[4][2];
#pragma unroll
    for (int r = 0; r < 4; ++r) { const int t = t0 + r * tstride;
        s0[r] = *(const float2*)(ostat + ((size_t)t * 8 + h) * 2); s1[r] = *(const float2*)(ostat + (((size_t)NTOK + t) * 8 + h) * 2);
        const f16x8* p0 = (const f16x8*)(opart + (size_t)t * 1024 + 16 * lane); const f16x8* p1 = (const f16x8*)(opart + ((size_t)NTOK + t) * 1024 + 16 * lane);
        u[r][0] = p0[0]; u[r][1] = p0[1]; v[r][0] = p1[0]; v[r][1] = p1[1]; }
#pragma unroll
    for (int r = 0; r < 4; ++r) { const int t = t0 + r * tstride;
        const float M = fmaxf(s0[r].x, s1[r].x);
        float a0 = s0[r].y * __builtin_amdgcn_exp2f((s0[r].x - M) * C2), a1 = s1[r].y * __builtin_amdgcn_exp2f((s1[r].x - M) * C2);
        const float inv = 1.0f / (a0 + a1); a0 *= inv; a1 *= inv;
        float y[16]; float ss = 0.f;
#pragma unroll
        for (int q = 0; q < 2; ++q)
#pragma unroll
            for (int i = 0; i < 8; ++i) { const float yy = a0 * (float)u[r][q][i] + a1 * (float)v[r][q][i]; y[q * 8 + i] = yy; ss += yy * yy; }
        const float rstd = rsqrtf(wsum_dpp(ss) * (1.0f / 1024.0f) + 1e-6f);
        u32x4 w0, w1;
        w0.x = pk2h(y[0] * rstd * gv[0], y[1] * rstd * gv[1]); w0.y = pk2h(y[2] * rstd * gv[2], y[3] * rstd * gv[3]); w0.z = pk2h(y[4] * rstd * gv[4], y[5] * rstd * gv[5]); w0.w = pk2h(y[6] * rstd * gv[6], y[7] * rstd * gv[7]);
        w1.x = pk2h(y[8] * rstd * gv[8], y[9] * rstd * gv[9]); w1.y = pk2h(y[10] * rstd * gv[10], y[11] * rstd * gv[11]); w1.z = pk2h(y[12] * rstd * gv[12], y[13] * rstd * gv[13]); w1.w = pk2h(y[14] * rstd * gv[14], y[15] * rstd * gv[15]);
        u32x4* dst = (u32x4*)(merged + (size_t)t * DM + DCONV + 16 * lane); dst[0] = w0; dst[1] = w1; }
}

__device__ __forceinline__ float wsum(float v) { return wsum_dpp(v); }
__device__ __forceinline__ void ph_h1_row(const float* x, const LAS float* tab, f16_t* out, int t, int lane) {
    const f32x4* xr = (const f32x4*)(x + (size_t)t * DM) + lane;
    f32x4 v[8]; float ss = 0.f;
#pragma unroll
    for (int j = 0; j < 8; ++j) { v[j] = xr[64 * j]; ss += (v[j][0] * v[j][0] + v[j][1] * v[j][1]) + (v[j][2] * v[j][2] + v[j][3] * v[j][3]); }
    const float rstd = rsqrtf(wsum(ss) * (1.0f / DM) + 1e-6f);
    const LAS f32x4* ta = (const LAS f32x4*)(tab + (t / SEQ) * 2 * DM) + lane; const LAS f32x4* tb = ta + DM / 4;
    u32x2* o = (u32x2*)(out + (size_t)t * DM) + lane;
#pragma unroll
    for (int j = 0; j < 8; ++j) { const f32x4 a = ta[64 * j], b = tb[64 * j]; const f32x4 h = v[j] * rstd * a + b;
        u32x2 w; w.x = pk2h(h[0], h[1]); w.y = pk2h(h[2], h[3]); o[64 * j] = w; }
}
__device__ __forceinline__ void rope32_chunk(float (&v)[16], int chunk, const float (&cs)[16], const float (&sn)[16]) {
#pragma unroll
    for (int j = 0; j < 16; ++j) { const float other = __shfl_xor(v[j], 1);
        if (chunk == 0) v[j] = v[j] * cs[j] - other * sn[j];
        else if (chunk == 1) v[j] = v[j] * cs[j] + other * sn[j]; }
}
__device__ __forceinline__ void ld16(const float* p, float (&v)[16]) {
#pragma unroll
    for (int i = 0; i < 4; ++i) { const f32x4 q = *(const f32x4*)(p + 4 * i); v[4 * i] = q[0]; v[4 * i + 1] = q[1]; v[4 * i + 2] = q[2]; v[4 * i + 3] = q[3]; }
}
__device__ __forceinline__ void ld16(const f16_t* p, float (&v)[16]) {
    const f16x8 a = ((const f16x8*)p)[0], b = ((const f16x8*)p)[1];
#pragma unroll
    for (int i = 0; i < 8; ++i) { v[i] = (float)a[i]; v[8 + i] = (float)b[i]; }
}
__device__ __forceinline__ void st16h(f16_t* p, const float (&v)[16]) {
    u32x4 a, b; a.x = pk2h(v[0], v[1]); a.y = pk2h(v[2], v[3]); a.z = pk2h(v[4], v[5]); a.w = pk2h(v[6], v[7]);
    b.x = pk2h(v[8], v[9]); b.y = pk2h(v[10], v[11]); b.z = pk2h(v[12], v[13]); b.w = pk2h(v[14], v[15]);
    ((u32x4*)p)[0] = a; ((u32x4*)p)[1] = b;
}
__device__ __forceinline__ void ph_rope_conv_row(const f16_t* proj, const int* positions, const float* cw, const float* g, f16_t* merged, f16_t* qh, f16_t* kh, f16_t* vh, f16_t* qih, f16_t* kih, float* wi, int t, int lane) {
    const f16_t* pr = proj + (size_t)t * DIN; const int pos = positions[t];
    float cmine, smine; rope_cs(pos, c_invf16[lane & 15], cmine, smine);
    float cs[16], sn[16];
#pragma unroll
    for (int j = 0; j < 16; ++j) { cs[j] = __shfl(cmine, j); sn[j] = __shfl(smine, j); }
    float v[16];
    ld16(pr + O_Q + 16 * lane, v); rope32_chunk(v, lane & 7, cs, sn); st16h(qh + (size_t)t * 1024 + 16 * lane, v);
    { const int l2 = lane & 15; ld16(pr + ((lane < 16) ? O_K : O_V) + 16 * l2, v); rope32_chunk(v, (lane < 16) ? (lane & 7) : 2, cs, sn);
      if (lane < 32) st16h(((lane < 16) ? kh : vh) + (size_t)t * 256 + 16 * l2, v); }
    ld16(pr + O_QI + 16 * lane, v);
    if ((lane & 3) == 0) {
#pragma unroll
        for (int j = 0; j < 8; ++j) { const float a = v[j], b = v[j + 8]; v[j] = a * cs[2 * j] - b * sn[2 * j]; v[j + 8] = b * cs[2 * j] + a * sn[2 * j]; } }
    st16h(qih + (size_t)t * 1024 + 16 * lane, v);
    ld16(pr + ((lane < 4) ? (O_KI + 16 * lane) : O_WI), v);
    if (lane == 0) {
#pragma unroll
        for (int j = 0; j < 8; ++j) { const float a = v[j], b = v[j + 8]; v[j] = a * cs[2 * j] - b * sn[2 * j]; v[j + 8] = b * cs[2 * j] + a * sn[2 * j]; } }
    if (lane < 4) st16h(kih + (size_t)t * 64 + 16 * lane, v);
    if (lane == 4) {
#pragma unroll
        for (int i = 0; i < 4; ++i) *(f32x4*)(wi + (size_t)t * 16 + 4 * i) = (f32x4){v[4 * i], v[4 * i + 1], v[4 * i + 2], v[4 * i + 3]}; }
    const int tl = t % SEQ, c0 = 16 * lane;
    float cg[16], u[16], y[16];
    ld16(pr + O_CG + c0, cg); ld16(pr + O_U + c0, u); ld16(cw + 2 * DCONV + c0, v);
#pragma unroll
    for (int i = 0; i < 16; ++i) y[i] = v[i] * (cg[i] * u[i]);
    if (tl >= 1) { ld16(pr - DIN + O_CG + c0, cg); ld16(pr - DIN + O_U + c0, u); ld16(cw + 1 * DCONV + c0, v);
#pragma unroll
        for (int i = 0; i < 16; ++i) y[i] += v[i] * (cg[i] * u[i]); }
    if (tl >= 2) { ld16(pr - 2 * DIN + O_CG + c0, cg); ld16(pr - 2 * DIN + O_U + c0, u); ld16(cw + c0, v);
#pragma unroll
        for (int i = 0; i < 16; ++i) y[i] += v[i] * (cg[i] * u[i]); }
    ld16(pr + O_BG + c0, v); float ss = 0.f;
#pragma unroll
    for (int i = 0; i < 16; ++i) { y[i] *= v[i]; ss += y[i] * y[i]; }
    const float rstd = rsqrtf(wsum(ss) * (1.0f / DCONV) + 1e-6f);
    ld16(g + c0, v);
#pragma unroll
    for (int i = 0; i < 16; ++i) y[i] = y[i] * rstd * v[i];
    st16h(merged + (size_t)t * DM + c0, y);
}
__device__ __forceinline__ void ph_post_row(const float* x, const float* mix, const LAS float* tab, float* x1, float* h2, unsigned char* h2q, int t, int lane) {
    const f32x4* mr = (const f32x4*)(mix + (size_t)t * DM) + lane; const f32x4* xr = (const f32x4*)(x + (size_t)t * DM) + lane;
    const LAS f32x4* t0 = (const LAS f32x4*)tab + lane;
    f32x4 m[8]; float ss = 0.f;
#pragma unroll
    for (int j = 0; j < 8; ++j) { m[j] = mr[64 * j]; ss += (m[j][0] * m[j][0] + m[j][1] * m[j][1]) + (m[j][2] * m[j][2] + m[j][3] * m[j][3]); }
    const float r1 = rsqrtf(wsum(ss) * (1.0f / DM) + 1e-6f);
    float s2 = 0.f;
#pragma unroll
    for (int j = 0; j < 8; ++j) { m[j] = xr[64 * j] + t0[64 * j] * (m[j] * r1 * t0[64 * j + DM / 4]); s2 += (m[j][0] * m[j][0] + m[j][1] * m[j][1]) + (m[j][2] * m[j][2] + m[j][3] * m[j][3]); }
    const float r2 = rsqrtf(wsum(s2) * (1.0f / DM) + 1e-6f);
    f32x4* xo = (f32x4*)(x1 + (size_t)t * DM) + lane; f32x4* ho = (f32x4*)(h2 + (size_t)t * DM) + lane; unsigned* hq = (unsigned*)(h2q + (size_t)t * DM) + lane;
#pragma unroll
    for (int j = 0; j < 8; ++j) { xo[64 * j] = m[j]; const f32x4 h = m[j] * r2 * t0[64 * j + 2 * (DM / 4)] + t0[64 * j + 3 * (DM / 4)]; ho[64 * j] = h;
        hq[64 * j] = pk4q(h[0], h[1], h[2], h[3]); }
}
__device__ __forceinline__ void ph_final_row(const float* x1, const f16_t* yrows, const int* topi, const float* gate, const int* slotpos, const LAS int* pst, const LAS float* tab, float* out, int t, int lane) {
    int rows[TK]; float gw_[TK];
#pragma unroll
    for (int k = 0; k < TK; ++k) { const int f = t * TK + k; rows[k] = pst[topi[f]] + slotpos[f]; gw_[k] = gate[f]; }
    float y[4][8]; float ss = 0.f;
#pragma unroll
    for (int j = 0; j < 4; ++j) {
#pragma unroll
        for (int i = 0; i < 8; ++i) y[j][i] = 0.f;
#pragma unroll
        for (int k = 0; k < TK; ++k) { const f16x8 r = *(const f16x8*)(yrows + (size_t)rows[k] * DM + 8 * lane + 512 * j);
#pragma unroll
            for (int i = 0; i < 8; ++i) y[j][i] += gw_[k] * (float)r[i]; }
#pragma unroll
        for (int i = 0; i < 8; ++i) ss += y[j][i] * y[j][i]; }
    const float r = rsqrtf(wsum(ss) * (1.0f / DM) + 1e-6f);
    const LAS float* tg = tab + (t / SEQ) * 2 * DM;
#pragma unroll
    for (int j = 0; j < 4; ++j) { const int col = 8 * lane + 512 * j;
#pragma unroll
        for (int q = 0; q < 2; ++q) { const f32x4 xv = *(const f32x4*)(x1 + (size_t)t * DM + col + 4 * q);
            const f32x4 g2 = *(const LAS f32x4*)(tg + col + 4 * q), gp = *(const LAS f32x4*)(tg + DM + col + 4 * q);
            f32x4 yv = (f32x4){y[j][4 * q], y[j][4 * q + 1], y[j][4 * q + 2], y[j][4 * q + 3]};
            *(f32x4*)(out + (size_t)t * DM + col + 4 * q) = xv + g2 * (yv * r * gp); } }
}
__device__ __forceinline__ void ph_router_mfma(const float* h2, const float* wr, LAS float* part, int tok0, int wv, int lane) {
    const int i = lane & 31, kk = lane >> 5, kb = 256 * wv + 128 * kk;
    const f32x4* ap = (const f32x4*)(h2 + (size_t)(tok0 + i) * DM + kb);
    const float* bp = wr + (size_t)kb * NE + i;
    f32x16 acc = {0.f, 0.f, 0.f, 0.f, 0.f, 0.f, 0.f, 0.f, 0.f, 0.f, 0.f, 0.f, 0.f, 0.f, 0.f, 0.f};
#pragma unroll 4
    for (int s4 = 0; s4 < 32; ++s4) { const f32x4 a = ap[s4];
#pragma unroll
        for (int u = 0; u < 4; ++u) acc = __builtin_amdgcn_mfma_f32_32x32x2f32(a[u], bp[(size_t)(4 * s4 + u) * NE], acc, 0, 0, 0); }
#pragma unroll
    for (int r = 0; r < 16; ++r) part[(wv * 32 + ((r & 3) + 8 * (r >> 2) + 4 * kk)) * 32 + i] = acc[r];
}

constexpr int N_PHASES = 12;
__global__ void __launch_bounds__(NT, 2) fwd(Args args) {
    extern __shared__ __attribute__((aligned(16))) unsigned char lds[];
    volatile LAS unsigned* MISC = (volatile LAS unsigned*)((LAS unsigned char*)lds + MISC_OFF);
    for (int u = threadIdx.x; u < (LDS_BYTES - MISC_OFF) / 4; u += NT) MISC[u] = 0u;
    __syncthreads();
    { XcdBarrier b0 = xcd_barrier_post((unsigned*)(args.ws + WS_CTL) + CW_BAR, MISC + 8); (void)b0; }
    if (threadIdx.x == 0) { MISC[16] = (unsigned)args.ph_lo; MISC[17] = (unsigned)args.ph_hi; MISC[18] = gridDim.x; }
    const int bx = blockIdx.x;
#define LO ((int)__builtin_amdgcn_readfirstlane((int)((LAS unsigned*)((LAS unsigned char*)lds + MISC_OFF))[16]))
#define HI ((int)__builtin_amdgcn_readfirstlane((int)((LAS unsigned*)((LAS unsigned char*)lds + MISC_OFF))[17]))
#define G ((int)__builtin_amdgcn_readfirstlane((int)((LAS unsigned*)((LAS unsigned char*)lds + MISC_OFF))[18]))
#ifndef REP_PHASE
#define REP_PHASE -1
#endif
#define IN(k) (LO <= (k) && (k) < HI)
#define PHASE(k) if (IN(k)) for (int rep_ = 0; rep_ < (((k) == REP_PHASE) ? 2 : 1); ++rep_)
#define SEAM(k) do { if (IN(k) && IN((k) + 1)) { XcdBarrier bar_; bar_.bar = (unsigned*)WSP(WS_CTL) + CW_BAR; bar_.x = xb_xcc_id(); bar_.st = MISC + 8; xcd_barrier(bar_); } } while (0)

    LAS unsigned long long* PT = (LAS unsigned long long*)((LAS unsigned char*)lds + MISC_OFF + 256);
#pragma unroll
    for (int k = 0; k < 20; ++k) if (threadIdx.x == k) PT[k] = (unsigned long long)args.in[k];
    if (threadIdx.x == 20) PT[20] = (unsigned long long)args.out;
    if (threadIdx.x == 21) PT[21] = (unsigned long long)args.ws;
    __syncthreads();
#define GASP __attribute__((address_space(1)))
#define LDP(k) ((unsigned char*)(GASP unsigned char*)(((unsigned long long)(unsigned)__builtin_amdgcn_readfirstlane((int)(unsigned)(PT[k] >> 32)) << 32) | (unsigned long long)(unsigned)__builtin_amdgcn_readfirstlane((int)(unsigned)PT[k])))
#define WSP(off) (LDP(21) + (off))
#define p_x ((const float*)LDP(0))
#define p_c ((const float*)LDP(1))
#define p_positions ((const int*)LDP(2))
#define p_w_ada ((const float*)LDP(3))
#define p_b_ada ((const float*)LDP(4))
#define p_g_pre_mix ((const float*)LDP(5))
#define p_g_post_mix ((const float*)LDP(6))
#define p_w_in ((const float*)LDP(7))
#define p_conv_w ((const float*)LDP(8))
#define p_g_conv_out ((const float*)LDP(9))
#define p_g_attn_out ((const float*)LDP(10))
#define p_w_out ((const float*)LDP(11))
#define p_g_pre_ffn ((const float*)LDP(12))
#define p_g_post_ffn ((const float*)LDP(13))
#define p_w_router ((const float*)LDP(14))
#define p_b_router ((const float*)LDP(15))
#define p_w_gate_up ((const float*)LDP(16))
#define p_b_gate_up ((const float*)LDP(17))
#define p_w_down ((const float*)LDP(18))
#define p_b_down ((const float*)LDP(19))
#define p_out ((float*)LDP(20))
#define p_adap ((float*)WSP(WS_ADAP))
#define p_ada ((float*)WSP(WS_ADA))
#define p_topi ((int*)WSP(WS_TOPI))
#define p_gate ((float*)WSP(WS_GATE))
#define p_lists ((int*)WSP(WS_LISTS))
#define p_counts ((int*)WSP(WS_CTL) + 2048)
#define p_slotpos ((int*)WSP(WS_SLOT))
#define p_tile_e ((int*)WSP(WS_COUNTS + 1024))
#define p_ntiles_p ((int*)WSP(WS_COUNTS + 2048))
#define p_sel ((int*)WSP(WS_SEL))
#define p_proj ((f16_t*)WSP(WS_PROJ))
#define p_scores ((float*)WSP(WS_SCORES))
#define p_mix ((float*)WSP(WS_MIX))
#define p_x1 ((float*)WSP(WS_X1))
#define p_h2 ((float*)WSP(WS_H2))
#define p_yrows ((f16_t*)WSP(WS_YROWS))
#define p_wtin ((f16_t*)WSP(WS_WTIN))
#define p_wtout ((f16_t*)WSP(WS_WTOUT))
#define p_wtgu ((f16_t*)WSP(WS_WTGU))
#define p_wtdn ((f16_t*)WSP(WS_WTDN))
#define p_h1h ((f16_t*)WSP(WS_H1H))
#define p_mergedh ((f16_t*)WSP(WS_MERGEDH))
#define p_h2h ((f16_t*)WSP(WS_H2H))
#define p_xg ((f16_t*)WSP(WS_XG))
#define p_acth ((f16_t*)WSP(WS_ACTH))
#define p_qh ((f16_t*)WSP(WS_QH))
#define p_kh ((f16_t*)WSP(WS_KH))
#define p_vh ((f16_t*)WSP(WS_VH))
#define p_qih ((f16_t*)WSP(WS_QIH))
#define p_kih ((f16_t*)WSP(WS_KIH))
#define p_wi ((float*)WSP(WS_WI))
#define p_maskp ((unsigned long long*)WSP(WS_MASK))
#define p_opart ((f16_t*)WSP(WS_OPART))
#define p_ostat ((float*)WSP(WS_OSTAT))
#define lane ((int)(threadIdx.x & 63))
#define wave (__builtin_amdgcn_readfirstlane((int)(threadIdx.x >> 6)))
#define gw (bx * 8 + wave)
#define NGW (G * 8)

    PHASE(0) { for (int vb = bx; vb < 24 * ADA_KC; vb += G) nb_ada_part(p_c, p_w_ada, p_adap, vb, lds);
        LAS float* scr = (LAS float*)((LAS unsigned char*)lds + wave * 16896);
        for (int it = gw; it < (DM / 64) * (DINP / 64); it += NGW) transpose_item(p_w_in, DM, DIN, p_wtin, scr, DINP / 64, it, lane);
        for (int it = gw; it < (DM / 64) * (DM / 64); it += NGW) transpose_item(p_w_out, DM, DM, p_wtout, scr, DM / 64, it, lane);
        __syncthreads(); }
    SEAM(0);
    PHASE(1) { LAS float* tab = (LAS float*)((LAS unsigned char*)lds);
        for (int i = threadIdx.x; i < NB * DM; i += NT) { const int b = i / DM, col = i % DM; float sc = p_b_ada[A_SC1 + col], sh = p_b_ada[A_SH1 + col];
#pragma unroll
            for (int kc = 0; kc < ADA_KC; ++kc) { sc += p_adap[(size_t)(kc * 2 + b) * (6 * DM) + A_SC1 + col]; sh += p_adap[(size_t)(kc * 2 + b) * (6 * DM) + A_SH1 + col]; }
            tab[b * 2 * DM + col] = p_g_pre_mix[col] * (1.0f + sc); tab[b * 2 * DM + DM + col] = sh; }
        for (int i = bx * NT + threadIdx.x; i < NB * 6 * DM; i += G * NT) { float a = p_b_ada[i % (6 * DM)];
#pragma unroll
            for (int kc = 0; kc < ADA_KC; ++kc) a += p_adap[(size_t)kc * 2 * (6 * DM) + i];
            p_ada[i] = a; }
        __syncthreads();
        for (int t = gw; t < NTOK; t += NGW) ph_h1_row(p_x, tab, p_h1h, t, lane);
        __syncthreads(); }
    SEAM(1);
    PHASE(2) { pg8::Gemm g{p_h1h, p_wtin, NTOK, DINP, DM}; pg8::StaticOrder S; S.init(NTOK, DINP, G, bx);
        pg8::EpiF16G E{p_proj, DIN, DIN};
        pg8::gemm_phase<pg8::EpiF16G, pg8::StaticOrder>((LAS unsigned char*)lds, g, S, E); }
    SEAM(2);
    PHASE(3) { for (int t = gw; t < NTOK; t += NGW) ph_rope_conv_row(p_proj, p_positions, p_conv_w, p_g_conv_out, p_mergedh, p_qh, p_kh, p_vh, p_qih, p_kih, p_wi, t, lane); }
    SEAM(3);
    PHASE(4) { for (int it = bx; it < 256; it += G) { const int b = it >> 7, p = it & 127;
            ph_scores_block(p_qih, p_kih, p_wi, p_scores, b * SEQ + 16 * p, (LAS unsigned char*)lds);
            ph_scores_block(p_qih, p_kih, p_wi, p_scores, b * SEQ + 16 * (255 - p), (LAS unsigned char*)lds);
            asm volatile("s_waitcnt vmcnt(0)" ::: "memory"); __syncthreads();
            ph_select_row(p_scores, p_maskp, b * SEQ + 16 * p + 2 * wave, lane); ph_select_row(p_scores, p_maskp, b * SEQ + 16 * p + 2 * wave + 1, lane);
            ph_select_row(p_scores, p_maskp, b * SEQ + 16 * (255 - p) + 2 * wave, lane); ph_select_row(p_scores, p_maskp, b * SEQ + 16 * (255 - p) + 2 * wave + 1, lane); } }
    SEAM(4);
    PHASE(5) { for (int item = bx; item < 256; item += G) { att::attn_block(att_ref(2 * item, p_qh, p_kh, p_vh, p_maskp, p_opart, p_ostat), (char*)lds);
                                                              att::attn_block(att_ref(2 * item + 1, p_qh, p_kh, p_vh, p_maskp, p_opart, p_ostat), (char*)lds); } }
    SEAM(5);
    PHASE(6) { for (int t = gw; t < NTOK; t += 4 * NGW) ph_merge_rows4(p_opart, p_ostat, p_g_attn_out, p_mergedh, t, NGW, lane); }
    SEAM(6);
    PHASE(7) { pg8::Gemm g{p_mergedh, p_wtout, NTOK, DM, DM}; pg8::StaticOrder S; S.init(NTOK, DM, G, bx);
        pg8::EpiF32G E{p_mix, DM, DM};
        pg8::gemm_phase<pg8::EpiF32G, pg8::StaticOrder>((LAS unsigned char*)lds, g, S, E); }
    SEAM(7);
    PHASE(8) { LAS float* tab = (LAS float*)((LAS unsigned char*)lds); LAS float* part = tab + 4 * DM; LAS float* lg = part + 8 * 32 * 32;
        LAS int* cnt = (LAS int*)(lg + 32 * NE); LAS int* basee = cnt + NE; LAS int* rnk = basee + NE; LAS int* eid = rnk + 32 * TK;
        for (int un = bx; un < NTOK / 32; un += G) { const int tok0 = un * 32, b = tok0 / SEQ;
            for (int col = threadIdx.x; col < DM; col += NT) { tab[col] = p_ada[b * 6 * DM + A_GT1 + col]; tab[DM + col] = p_g_post_mix[col];
                tab[2 * DM + col] = p_g_pre_ffn[col] * (1.0f + p_ada[b * 6 * DM + A_SC2 + col]); tab[3 * DM + col] = p_ada[b * 6 * DM + A_SH2 + col]; }
            if (threadIdx.x < NE) cnt[threadIdx.x] = 0;
            __syncthreads();
            for (int i = 0; i < 4; ++i) ph_post_row(p_x, p_mix, tab, p_x1, p_h2, (unsigned char*)p_h2h, tok0 + 4 * wave + i, lane);
            asm volatile("s_waitcnt vmcnt(0)" ::: "memory"); __syncthreads();
            ph_router_mfma(p_h2, p_w_router, part, tok0, wave, lane);
            __syncthreads();
            { const int tk = threadIdx.x >> 4, e0 = (threadIdx.x & 15) * 2; float a0 = p_b_router[e0], a1 = p_b_router[e0 + 1];
#pragma unroll
              for (int w8 = 0; w8 < 8; ++w8) { a0 += part[(w8 * 32 + tk) * 32 + e0]; a1 += part[(w8 * 32 + tk) * 32 + e0 + 1]; }
              lg[tk * NE + e0] = a0; lg[tk * NE + e0 + 1] = a1; }
            __syncthreads();
            if (threadIdx.x < 32) { const int tk = threadIdx.x; float v[NE];
#pragma unroll
                for (int i = 0; i < NE; ++i) v[i] = lg[tk * NE + i];
                int idx[TK]; float val[TK];
#pragma unroll
                for (int k = 0; k < TK; ++k) { float best = -INFINITY; int bi = 0;
#pragma unroll
                    for (int i = 0; i < NE; ++i) { const bool take = v[i] > best; best = take ? v[i] : best; bi = take ? i : bi; }
                    idx[k] = bi; val[k] = best;
#pragma unroll
                    for (int i = 0; i < NE; ++i) v[i] = (i == bi) ? -INFINITY : v[i]; }
                float sm = 0.f, ex[TK];
#pragma unroll
                for (int k = 0; k < TK; ++k) { ex[k] = __expf(val[k] - val[0]); sm += ex[k]; }
#pragma unroll
                for (int k = 0; k < TK; ++k) { const int f = (tok0 + tk) * TK + k; p_topi[f] = idx[k]; p_gate[f] = ex[k] / sm;
                    eid[tk * TK + k] = idx[k]; rnk[tk * TK + k] = atomicAdd((int*)&cnt[idx[k]], 1); } }
            __syncthreads();
            if (threadIdx.x < NE) basee[threadIdx.x] = atomicAdd(&p_counts[threadIdx.x], cnt[threadIdx.x]);
            __syncthreads();
            if (threadIdx.x < 32 * TK) { const int f = tok0 * TK + threadIdx.x, e = eid[threadIdx.x], pos = basee[e] + rnk[threadIdx.x];
                p_lists[(size_t)e * NTOK + pos] = f; p_slotpos[f] = pos; }
            __syncthreads(); } }
    SEAM(8);
#define T_TE ((LAS int*)((LAS unsigned char*)lds + MISC_OFF + 1024))
#define T_TJ ((LAS int*)((LAS unsigned char*)lds + MISC_OFF + 1024 + 640))
#define T_PST ((LAS int*)((LAS unsigned char*)lds + MISC_OFF + 1024 + 1280))
#define T_CN ((LAS int*)((LAS unsigned char*)lds + MISC_OFF + 1024 + 1280 + 160))
#define T_NT ((LAS int*)((LAS unsigned char*)lds + MISC_OFF + 1024 + 1280 + 160 + 128))
    PHASE(9) {
        if (threadIdx.x == 0) { int tl = 0; for (int e = 0; e < NE; ++e) { const int cc = p_counts[e], nt_e = (cc + 255) >> 8; T_CN[e] = cc; T_PST[e] = tl * 256;
                for (int j = 0; j < nt_e; ++j) { T_TE[tl] = e; T_TJ[tl] = j; ++tl; } } T_PST[NE] = tl * 256; T_NT[0] = tl; }
        __syncthreads();
        unsigned* ctlw = (unsigned*)WSP(WS_CTL);
        constexpr int NCV = 3;
        const bool conv_all = (G != 256);
        if (conv_all || ((bx >> 3) & 7) < NCV) {
            LAS float* scq = (LAS float*)((LAS unsigned char*)lds + wave * 16896);
            const int crank = (bx >> 6) * (8 * NCV) + ((bx >> 3) & 7) * 8 + (bx & 7);
            for (unsigned it = conv_all ? (unsigned)bx : (unsigned)__builtin_amdgcn_readfirstlane(crank); it < 768u; it += conv_all ? (unsigned)G : 32u * NCV) {
                if (it < 512u) { const int e = (int)(it >> 4), part = (int)(it & 15);
                    tq_run16(p_w_gate_up + (size_t)e * DM * 2 * DFF, (unsigned char*)p_wtgu + (size_t)e * 2 * DFF * DM, DM, 2 * DFF, 32 * (part * 8 + wave), scq, lane, 32.0f);
                    asm volatile("s_waitcnt vmcnt(0)" ::: "memory"); __syncthreads();
                    if (threadIdx.x == 0) __hip_atomic_fetch_add(ctlw + CW_RDY0 + 64 * e, 1u, __ATOMIC_RELAXED, __HIP_MEMORY_SCOPE_AGENT); }
                else { const int e = (int)((it - 512u) >> 3), part = (int)((it - 512u) & 7);
                    tq_run16(p_w_down + (size_t)e * DFF * DM, (unsigned char*)p_wtdn + (size_t)e * DM * DFF, DFF, DM, 32 * (part * 8 + wave), scq, lane, 32.0f); }
            }
            asm volatile("s_waitcnt vmcnt(0)" ::: "memory"); __syncthreads();
        }
        pg8::Gemm g{p_h2h, p_wtgu, PMAX, 2 * DFF, DM / 2};
        pg8::DynOrderG S{2 * DFF / 256, T_NT[0], T_TE, T_TJ, T_CN, p_lists, (size_t)2 * DFF * DM, ctlw + CW_GQ, ctlw + CW_RDY0, 16u, ctlw + CW_TMO2, MISC + 26, -1};
        pg8::EpiSwigluQ E{(unsigned char*)p_acth, DFF, p_b_gate_up, 2 * DFF};
        pg8::gemm_phase<pg8::EpiSwigluQ, pg8::DynOrderG, false, true>((LAS unsigned char*)lds, g, S, E); }
    SEAM(9);
    PHASE(10) { pg8::Gemm g{p_acth, p_wtdn, PMAX, DM, DFF / 2}; pg8::GroupedOrder<false> S{DM / 256, G, bx, T_NT[0], T_TE, T_TJ, T_CN, p_lists, (size_t)DM * DFF};
        pg8::EpiF16Bias E{p_yrows, DM, p_b_down, DM};
        pg8::gemm_phase<pg8::EpiF16Bias, pg8::GroupedOrder<false>, false, true>((LAS unsigned char*)lds, g, S, E); }
    SEAM(10);
    PHASE(11) { LAS float* tab = (LAS float*)((LAS unsigned char*)lds + 1024);
        for (int i = threadIdx.x; i < NB * DM; i += NT) { const int b = i / DM, col = i % DM; tab[b * 2 * DM + col] = p_ada[b * 6 * DM + A_GT2 + col]; tab[b * 2 * DM + DM + col] = p_g_post_ffn[col]; }
        __syncthreads();
        for (int t = gw; t < NTOK; t += NGW) ph_final_row(p_x1, p_yrows, p_topi, p_gate, p_slotpos, T_PST, tab, p_out, t, lane); }
#undef T_TE
#undef T_TJ
#undef T_PST
#undef T_CN
#undef T_NT
#undef IN
#undef PHASE
#undef SEAM
#undef LO
#undef HI
#undef G
#undef NGW
}
#undef lane
#undef wave
#undef gw

extern "C" void kernel_launch(void* const* d_in, const int* in_sizes, int n_in, void* d_out, int out_size, void* d_ws, size_t ws_size, hipStream_t stream) {
    static int grid = 0;
    if (grid == 0) {
        if (n_in != 20 || ws_size < WS_END) { fprintf(stderr, "kernel_launch: unexpected n_in %d or ws_size %zu\n", n_in, ws_size); grid = -1; return; }
        int dev = 0, cus = 0, per_cu = 0;
        if (hipGetDevice(&dev) != hipSuccess || hipDeviceGetAttribute(&cus, hipDeviceAttributeMultiprocessorCount, dev) != hipSuccess) { grid = -1; return; }
        if (hipFuncSetAttribute((const void*)fwd, hipFuncAttributeMaxDynamicSharedMemorySize, LDS_BYTES) != hipSuccess) { fprintf(stderr, "kernel_launch: hipFuncSetAttribute failed\n"); grid = -1; return; }
        if (hipOccupancyMaxActiveBlocksPerMultiprocessor(&per_cu, (const void*)fwd, NT, LDS_BYTES) != hipSuccess || per_cu < 1) fprintf(stderr, "kernel_launch: occupancy query says %d\n", per_cu);
        (void)hipGetLastError();
        grid = cus;
    }
    if (grid < 0) return;
    if (hipMemsetAsync((char*)d_ws + WS_CTL, 0, CTL_ZERO_BYTES, stream) != hipSuccess) return;
    Args a{};
    for (int i = 0; i < 20; ++i) a.in[i] = d_in[i];
    a.out = (float*)d_out; a.ws = (unsigned char*)d_ws; a.ph_lo = 0; a.ph_hi = N_PHASES;
    hipLaunchKernelGGL(fwd, dim3(grid), dim3(NT), LDS_BYTES, stream, a);
}
```

```cpp
#include <hip/hip_runtime.h>
#include <cstdint>
#include <cstddef>
#include <cstdio>

#define NTOK 8192
#define SEQ 4096
#define NB 2
#define DM 2048
#define DCONV 1024
#define NH 8
#define NKV 2
#define HD 128
#define IH 16
#define IDIM 64
#define TOPK 256
#define DIN 5712
#define NE 32
#define TK 4
#define DFF 2048
#define NROWS (NTOK * TK)
#define O_BG 0
#define O_CG 1024
#define O_U 2048
#define O_Q 3072
#define O_K 4096
#define O_V 4352
#define O_QI 4608
#define O_KI 5632
#define O_WI 5696
#define A_SH1 0
#define A_SC1 2048
#define A_GT1 4096
#define A_SH2 6144
#define A_SC2 8192
#define A_GT2 10240
#define NT 512
#define ADA_KC 8

#define LAS __attribute__((address_space(3)))

__device__ __constant__ float c_invf16[16] = {1.000000000e+00f, 4.403665960e-01f, 1.939227432e-01f, 8.539710194e-02f, 3.760603070e-02f, 1.656044088e-02f, 7.292664610e-03f, 3.211446106e-03f,
                                               1.414213562e-03f, 6.227724371e-04f, 2.742481884e-04f, 1.207697351e-04f, 5.318295734e-05f, 2.341999971e-05f, 1.031338525e-05f, 4.541670478e-06f};

#define XB_TMO      128
#define XB_XCNT(j)  (256  + 64 * (j))
#define XB_XSUB(j)  (1280 + 64 * (j))
#define XB_XGEN(j)  (2304 + 64 * (j))
#define XB_TOP      3328
#define XB_TOPGEN   3392
#define XCD_BAR_WORDS 3456
#define XB_SPIN_CAP (1u << 18)

__device__ __forceinline__ unsigned xb_ld(unsigned* p)              { return __hip_atomic_load(p, __ATOMIC_RELAXED, __HIP_MEMORY_SCOPE_AGENT); }
__device__ __forceinline__ unsigned xb_add(unsigned* p, unsigned v) { return __hip_atomic_fetch_add(p, v, __ATOMIC_RELAXED, __HIP_MEMORY_SCOPE_AGENT); }
__device__ __forceinline__ unsigned xb_xcc_id() { return (unsigned)__builtin_amdgcn_s_getreg((3 << 11) | 20) & 0xFu; }
#define XB_SPIN(cond, bar) do { unsigned _sp = 0; while (cond) { __builtin_amdgcn_s_sleep(1); \
    if ((++_sp & 255u) == 0u) { if (xb_ld(&(bar)[XB_TMO])) break; if (_sp > XB_SPIN_CAP) { atomicAdd(&(bar)[XB_TMO], 1u); break; } } } } while (0)

struct XcdBarrier { unsigned* bar; unsigned x; volatile LAS unsigned* st; };

__device__ __forceinline__ XcdBarrier xcd_barrier_post(unsigned* bar, volatile LAS unsigned* st) {
    XcdBarrier b; b.bar = bar; b.x = xb_xcc_id(); b.st = st;
    if (threadIdx.x == 0) (void)xb_add(&bar[XB_XCNT(b.x)], 1u);
    return b;
}
__device__ __forceinline__ void xcd_barrier_complete(unsigned* bar, unsigned x, unsigned& nloc, unsigned& nx) {
    const unsigned G = gridDim.x * gridDim.y * gridDim.z;
    unsigned sum, cnt, mine, sp = 0u;
    for (;;) {
        sum = 0u; cnt = 0u; mine = 0u;
#pragma unroll
        for (unsigned j = 0; j < 16; ++j) { const unsigned c = xb_ld(&bar[XB_XCNT(j)]); sum += c; cnt += (c > 0u) ? 1u : 0u; mine = (j == x) ? c : mine; }
        if (sum == G) break;
        __builtin_amdgcn_s_sleep(1);
        if ((++sp & 255u) == 0u) { if (xb_ld(&bar[XB_TMO])) break; if (sp > XB_SPIN_CAP) { atomicAdd(&bar[XB_TMO], 1u); break; } }
    }
    nloc = mine > 0u ? mine : 1u; nx = cnt > 0u ? cnt : 1u;
}
__device__ __forceinline__ void xcd_barrier(const XcdBarrier& b) {
    asm volatile("s_waitcnt vmcnt(0)" ::: "memory");
    __syncthreads();
    if (threadIdx.x == 0) {
        unsigned* bar = b.bar;
        __builtin_amdgcn_s_waitcnt(0);
        unsigned nloc = b.st[0], nx = b.st[1];
        if (nloc == 0u) { xcd_barrier_complete(bar, b.x, nloc, nx); b.st[0] = nloc; b.st[1] = nx; }
        const unsigned old = xb_add(&bar[XB_XSUB(b.x)], 1u);
        const unsigned gen = old / nloc;
        if (old + 1u == (gen + 1u) * nloc) {
            __builtin_amdgcn_fence(__ATOMIC_RELEASE, "agent");
            asm volatile("s_waitcnt vmcnt(0)" ::: "memory");
            const unsigned og = xb_add(&bar[XB_TOP], 1u);
            const unsigned tg = og / nx;
            if (og + 1u == (tg + 1u) * nx) xb_add(&bar[XB_TOPGEN], 1u);
            else XB_SPIN(xb_ld(&bar[XB_TOPGEN]) == tg, bar);
            __builtin_amdgcn_fence(__ATOMIC_ACQUIRE, "agent");
            xb_add(&bar[XB_XGEN(b.x)], 1u);
            asm volatile("s_waitcnt vmcnt(0)" ::: "memory");
        } else {
            XB_SPIN(xb_ld(&bar[XB_XGEN(b.x)]) == gen, bar);
            __builtin_amdgcn_fence(__ATOMIC_ACQUIRE, "agent");
            asm volatile("s_waitcnt vmcnt(0)" ::: "memory");
        }
    }
    __syncthreads();
}


typedef unsigned short f16_t;
typedef _Float16 f16x8 __attribute__((ext_vector_type(8)));
typedef _Float16 f16x2 __attribute__((ext_vector_type(2)));
typedef float f32x4 __attribute__((ext_vector_type(4)));
typedef unsigned u32x4 __attribute__((ext_vector_type(4)));
typedef unsigned u32x2 __attribute__((ext_vector_type(2)));
typedef int v4i_t __attribute__((ext_vector_type(4)));
typedef short s16x4_t __attribute__((ext_vector_type(4)));
typedef short s16x8_t __attribute__((ext_vector_type(8)));
typedef int v8i_t __attribute__((ext_vector_type(8)));
__device__ __forceinline__ unsigned pk4q(float a, float b, float c, float d) { int w = __builtin_amdgcn_cvt_pk_fp8_f32(a, b, 0, false); w = __builtin_amdgcn_cvt_pk_fp8_f32(c, d, w, true); return (unsigned)w; }
__device__ __forceinline__ unsigned pk2h(float lo, float hi) { f16x2 h; h.x = (_Float16)lo; h.y = (_Float16)hi; return __builtin_bit_cast(unsigned, h); }

namespace pg8 {
constexpr int BM = 256, BK = 64, HALF = 128, HTB = HALF * BK * 2, STAGE_BYTES = 8 * HTB, NXCD = 8, WGM = 8;
__host__ __device__ __forceinline__ int lds_byte(int r, int c) { const int st = (r >> 4) * 2 + (c >> 5), rr = r & 15, cc = c & 31, ob = rr * 64 + cc * 2; return st * 1024 + (ob ^ (((ob >> 9) & 1) << 5)); }
__host__ __device__ __forceinline__ void stage_rc(int b, int& R, int& C) { const int st = b / 1024, sb = b % 1024, swz = sb ^ (((sb >> 9) & 1) << 5); R = (st >> 1) * 16 + swz / 64; C = (st & 1) * 32 + (swz % 64) / 2; }
__host__ __device__ __forceinline__ int perm32(int rho) { const int n = rho >> 4, i = rho & 15; return 8 * (i >> 2) + 4 * n + (i & 3); }

struct Unit { int pm, pn, e; size_t boff; };
struct Gemm { const f16_t* A; const f16_t* Bt; int M, N, K; };

struct StaticOrder {
    int nM, nN, nwg, G, c;
    __host__ __device__ void init(int M, int N, int G_, int c_) { nM = M / BM; nN = N / BM; nwg = nM * nN; G = G_; c = c_; }
    __host__ __device__ bool next(int i, Unit& u) const {
        const long L = (long)i * G + c; if (L >= nwg) return false;
        int wgid = (int)L; { const int q = nwg / NXCD, r = nwg % NXCD, xcd = wgid % NXCD, off = wgid / NXCD; wgid = (xcd < r ? xcd * (q + 1) : r * (q + 1) + (xcd - r) * q) + off; }
        const int nig = WGM * nN, gid = wgid / nig, fm = gid * WGM, gsz = (nM - fm) < WGM ? (nM - fm) : WGM;
        u.pm = fm + ((wgid % nig) % gsz); u.pn = (wgid % nig) / gsz; u.boff = 0; u.e = 0; return true;
    }
    __device__ __forceinline__ unsigned a_off(const Unit& u, int h, int R, int K) const { return (unsigned)((u.pm * BM + h * HALF + R) * K) * 2u; }
    __device__ __forceinline__ void a_ready(const Unit&) const {}
    __device__ __forceinline__ void done(const Unit&) const {}
};

struct EpiF32G {
    static constexpr bool PERM = false, AFTER_DRAIN = false;
    float* C; int ldc; int ncols;
    __device__ __forceinline__ void operator()(const f32x4 (&acc)[2][2][4][2], const Unit& u, int wr, int wc, int fr, int fq) const {
        const int row0 = u.pm * BM + wr * 64 + fr, col0 = u.pn * BM + wc * 32 + 4 * fq;
#pragma unroll
        for (int ai = 0; ai < 2; ++ai)
#pragma unroll
            for (int m = 0; m < 4; ++m) { float* rowp = C + (size_t)(row0 + ai * HALF + m * 16) * ldc + col0;
#pragma unroll
                for (int bj = 0; bj < 2; ++bj)
#pragma unroll
                    for (int n = 0; n < 2; ++n) if (col0 + bj * HALF + n * 16 < ncols) *(f32x4*)(rowp + bj * HALF + n * 16) = acc[ai][bj][m][n]; }
    }
};

struct EpiF16G {
    static constexpr bool PERM = true, AFTER_DRAIN = false;
    f16_t* C; int ldc; int ncols;
    __device__ __forceinline__ void operator()(const f32x4 (&acc)[2][2][4][2], const Unit& u, int wr, int wc, int fr, int fq) const {
        const int row0 = u.pm * BM + wr * 64 + fr, col0 = u.pn * BM + wc * 32 + 8 * fq;
#pragma unroll
        for (int ai = 0; ai < 2; ++ai)
#pragma unroll
            for (int m = 0; m < 4; ++m) { f16_t* rowp = C + (size_t)(row0 + ai * HALF + m * 16) * ldc + col0;
#pragma unroll
                for (int bj = 0; bj < 2; ++bj) if (col0 + bj * HALF < ncols) { const f32x4 v0 = acc[ai][bj][m][0], v1 = acc[ai][bj][m][1];
                    u32x4 w; w.x = pk2h(v0[0], v0[1]); w.y = pk2h(v0[2], v0[3]); w.z = pk2h(v1[0], v1[1]); w.w = pk2h(v1[2], v1[3]);
                    *(u32x4*)(rowp + bj * HALF) = w; } }
    }
};
struct EpiF16Bias {
    static constexpr bool PERM = true, AFTER_DRAIN = false;
    f16_t* C; int ldc; const float* bias; int nbias;
    __device__ __forceinline__ void operator()(const f32x4 (&acc)[2][2][4][2], const Unit& u, int wr, int wc, int fr, int fq) const {
        const int row0 = u.pm * BM + wr * 64 + fr, col0 = u.pn * BM + wc * 32 + 8 * fq;
        const float* bp = bias + (size_t)u.e * nbias + col0;
        f32x4 bv[2][2];
#pragma unroll
        for (int bj = 0; bj < 2; ++bj)
#pragma unroll
            for (int n = 0; n < 2; ++n) bv[bj][n] = *(const f32x4*)(bp + bj * HALF + 4 * n);
#pragma unroll
        for (int ai = 0; ai < 2; ++ai)
#pragma unroll
            for (int m = 0; m < 4; ++m) { f16_t* rowp = C + (size_t)(row0 + ai * HALF + m * 16) * ldc + col0;
#pragma unroll
                for (int bj = 0; bj < 2; ++bj) { const f32x4 v0 = acc[ai][bj][m][0] + bv[bj][0], v1 = acc[ai][bj][m][1] + bv[bj][1];
                    u32x4 w; w.x = pk2h(v0[0], v0[1]); w.y = pk2h(v0[2], v0[3]); w.z = pk2h(v1[0], v1[1]); w.w = pk2h(v1[2], v1[3]);
                    *(u32x4*)(rowp + bj * HALF) = w; } }
    }
};
struct EpiF16BiasN {
    static constexpr bool PERM = false, AFTER_DRAIN = false;
    f16_t* C; int ldc; const float* bias; int nbias;
    __device__ __forceinline__ void operator()(const f32x4 (&acc)[2][2][4][2], const Unit& u, int wr, int wc, int fr, int fq) const {
        const int row0 = u.pm * BM + wr * 64 + fr, col0 = u.pn * BM + wc * 32 + 4 * fq;
        const float* bp = bias + (size_t)u.e * nbias + col0;
        f32x4 bv[2][2];
#pragma unroll
        for (int bj = 0; bj < 2; ++bj)
#pragma unroll
            for (int n = 0; n < 2; ++n) bv[bj][n] = *(const f32x4*)(bp + bj * HALF + 16 * n);
#pragma unroll
        for (int ai = 0; ai < 2; ++ai)
#pragma unroll
            for (int m = 0; m < 4; ++m) { f16_t* rowp = C + (size_t)(row0 + ai * HALF + m * 16) * ldc + col0;
#pragma unroll
                for (int bj = 0; bj < 2; ++bj)
#pragma unroll
                    for (int n = 0; n < 2; ++n) { const f32x4 v = acc[ai][bj][m][n] + bv[bj][n]; u32x2 w; w.x = pk2h(v[0], v[1]); w.y = pk2h(v[2], v[3]); *(u32x2*)(rowp + bj * HALF + 16 * n) = w; } }
    }
};
template <bool GATHER> struct GroupedOrder {
    int nN, G, c, ntiles; const LAS int* te; const LAS int* tj; const LAS int* cn; const int* lists; size_t estride;
    __device__ __forceinline__ bool next(int i, Unit& u) const {
        if (G == 256 && nN == 8) {
            const int q = c & 7, w = c >> 3;
            u.pm = i * 32 + q * 4 + (w >> 3); u.pn = w & 7; if (u.pm >= ntiles) return false;
            u.e = te[u.pm]; u.boff = (size_t)u.e * estride; return true; }
        const long L = (long)i * G + c; if (L >= (long)ntiles * nN) return false;
        u.pm = (int)(L / nN); u.pn = (int)(L % nN); u.e = te[u.pm]; u.boff = (size_t)u.e * estride; return true;
    }
    __device__ __forceinline__ unsigned a_off(const Unit& u, int h, int R, int K) const {
        if (GATHER) { const int i = tj[u.pm] * BM + h * HALF + R; const int src = (i < cn[u.e]) ? (lists[(size_t)u.e * NTOK + i] >> 2) : 0; return (unsigned)(src * K) * 2u; }
        return (unsigned)((u.pm * BM + h * HALF + R) * K) * 2u;
    }
    __device__ __forceinline__ void a_ready(const Unit&) const {}
    __device__ __forceinline__ void done(const Unit&) const {}
};
template <int NN, bool GATHER> struct DynOrderT {
    int nN, ntiles; const LAS int* te; const LAS int* tj; const LAS int* cn; const int* lists; size_t estride;
    unsigned* qhead; unsigned* ready; unsigned need; unsigned* tmo; volatile LAS unsigned* slot; mutable int seen_e; unsigned xq;
    __device__ __forceinline__ bool next(int i, Unit& u) const {
        if (threadIdx.x == 0) { unsigned Lq = 0xFFFFFFFFu;
            for (int a_ = 0; a_ < 8; ++a_) { const unsigned q = (xq + (unsigned)a_) & 7u;
                const unsigned idx = __hip_atomic_fetch_add(qhead + 32 * q, 1u, __ATOMIC_RELAXED, __HIP_MEMORY_SCOPE_AGENT);
                const unsigned pm_ = ((idx / (2u * NN)) * 8u + q) * 2u + ((idx / NN) & 1u);
                if (pm_ < (unsigned)ntiles) { Lq = pm_ * NN + (idx % NN); break; } }
            slot[i & 1] = Lq; }
        asm volatile("s_waitcnt lgkmcnt(0)" ::: "memory"); __builtin_amdgcn_s_barrier(); asm volatile("" ::: "memory");
        const unsigned L = slot[i & 1];
        if (L >= (unsigned)(ntiles * nN)) return false;
        u.pm = (int)(L / (unsigned)nN); u.pn = (int)(L % (unsigned)nN); u.e = te[u.pm]; u.boff = (size_t)u.e * estride; return true;
    }
    __device__ __forceinline__ unsigned a_off(const Unit& u, int h, int R, int K) const {
        if (!GATHER) return (unsigned)((u.pm * BM + h * HALF + R) * K) * 2u;
        const int i = tj[u.pm] * BM + h * HALF + R; const int src = (i < cn[u.e]) ? (lists[(size_t)u.e * NTOK + i] >> 2) : 0; return (unsigned)(src * K) * 2u;
    }
    __device__ __forceinline__ void a_ready(const Unit& u) const {
        if (need == 0u) return;
        if (u.e == seen_e) return;
        seen_e = u.e;
        if (threadIdx.x < 64) { unsigned sp = 0;
            while ((unsigned)__builtin_amdgcn_readfirstlane((int)__hip_atomic_load(ready + 64 * u.e, __ATOMIC_RELAXED, __HIP_MEMORY_SCOPE_AGENT)) < need) {
                __builtin_amdgcn_s_sleep(4);
                if ((++sp & 255u) == 0u) { if (__builtin_amdgcn_readfirstlane((int)__hip_atomic_load(tmo, __ATOMIC_RELAXED, __HIP_MEMORY_SCOPE_AGENT)) != 0) break;
                    if (sp > (1u << 17)) { if (threadIdx.x == 0) __hip_atomic_store(tmo, 1u, __ATOMIC_RELAXED, __HIP_MEMORY_SCOPE_AGENT); break; } } }
            __builtin_amdgcn_fence(__ATOMIC_ACQUIRE, "agent");
            asm volatile("s_waitcnt vmcnt(0)" ::: "memory"); }
        asm volatile("" ::: "memory"); __builtin_amdgcn_s_barrier(); asm volatile("" ::: "memory");
    }
    __device__ __forceinline__ void done(const Unit&) const {}
};
template <bool PERM_> struct EpiSwigluT {
    static constexpr bool PERM = PERM_, AFTER_DRAIN = false;
    f16_t* O; int ldo; const float* bias; int nbias;
    static __device__ __forceinline__ float act1(float g_, float u_) { const float gt = fminf(g_, 7.0f), up = fminf(fmaxf(u_, -7.0f), 7.0f);
        return gt * __builtin_amdgcn_rcpf(1.0f + __builtin_amdgcn_exp2f(gt * (-1.702f * 1.4426950408889634f))) * (up + 1.0f); }
    __device__ __forceinline__ void operator()(const f32x4 (&acc)[2][2][4][2], const Unit& u, int wr, int wc, int fr, int fq) const {
        const int row0 = u.pm * BM + wr * 64 + fr, col0 = u.pn * BM + wc * 32 + (PERM_ ? 8 : 4) * fq;
        const float* bp = bias + (size_t)u.e * nbias + col0;
        f32x4 bv[2][2];
#pragma unroll
        for (int bj = 0; bj < 2; ++bj)
#pragma unroll
            for (int n = 0; n < 2; ++n) bv[bj][n] = *(const f32x4*)(bp + bj * HALF + (PERM_ ? 4 : 16) * n);
#pragma unroll
        for (int ai = 0; ai < 2; ++ai)
#pragma unroll
            for (int m = 0; m < 4; ++m) { f16_t* rowp = O + (size_t)(row0 + ai * HALF + m * 16) * ldo + (col0 >> 1);
#pragma unroll
                for (int bj = 0; bj < 2; ++bj) { const f32x4 v0 = acc[ai][bj][m][0] + bv[bj][0], v1 = acc[ai][bj][m][1] + bv[bj][1];
                    const unsigned w0 = pk2h(act1(v0[0], v0[1]), act1(v0[2], v0[3])), w1 = pk2h(act1(v1[0], v1[1]), act1(v1[2], v1[3]));
                    if (PERM_) { u32x2 w; w.x = w0; w.y = w1; *(u32x2*)(rowp + bj * (HALF / 2)) = w; }
                    else { *(unsigned*)(rowp + bj * (HALF / 2)) = w0; *(unsigned*)(rowp + bj * (HALF / 2) + 8) = w1; } } }
    }
};
typedef DynOrderT<16, true> DynOrderG;
typedef DynOrderT<8, false> DynOrderD;
typedef EpiSwigluT<true> EpiSwiglu;
struct EpiSwigluQ {
    static constexpr bool PERM = true, AFTER_DRAIN = false;
    unsigned char* O; int ldo; const float* bias; int nbias;
    __device__ __forceinline__ void operator()(const f32x4 (&acc)[2][2][4][2], const Unit& u, int wr, int wc, int fr, int fq) const {
        const int row0 = u.pm * BM + wr * 64 + fr, col0 = u.pn * BM + wc * 32 + 8 * fq;
        const float* bp = bias + (size_t)u.e * nbias + col0;
        f32x4 bv[2][2];
#pragma unroll
        for (int bj = 0; bj < 2; ++bj)
#pragma unroll
            for (int n = 0; n < 2; ++n) bv[bj][n] = *(const f32x4*)(bp + bj * HALF + 4 * n);
#pragma unroll
        for (int ai = 0; ai < 2; ++ai)
#pragma unroll
            for (int m = 0; m < 4; ++m) { unsigned char* rowp = O + (size_t)(row0 + ai * HALF + m * 16) * ldo + (col0 >> 1);
#pragma unroll
                for (int bj = 0; bj < 2; ++bj) { const f32x4 v0 = acc[ai][bj][m][0] + bv[bj][0], v1 = acc[ai][bj][m][1] + bv[bj][1];
                    *(unsigned*)(rowp + bj * (HALF / 2)) = pk4q(EpiSwigluT<true>::act1(v0[0], v0[1]), EpiSwigluT<true>::act1(v0[2], v0[3]), EpiSwigluT<true>::act1(v1[0], v1[1]), EpiSwigluT<true>::act1(v1[2], v1[3])); } }
    }
};
struct EpiF32Bias {
    static constexpr bool PERM = false, AFTER_DRAIN = false;
    float* C; int ldc; const float* bias; int nbias;
    __device__ __forceinline__ void operator()(const f32x4 (&acc)[2][2][4][2], const Unit& u, int wr, int wc, int fr, int fq) const {
        const int row0 = u.pm * BM + wr * 64 + fr, col0 = u.pn * BM + wc * 32 + 4 * fq;
        const float* bp = bias + (size_t)u.e * nbias + col0;
        f32x4 bv[2][2];
#pragma unroll
        for (int bj = 0; bj < 2; ++bj)
#pragma unroll
            for (int n = 0; n < 2; ++n) bv[bj][n] = *(const f32x4*)(bp + bj * HALF + n * 16);
#pragma unroll
        for (int ai = 0; ai < 2; ++ai)
#pragma unroll
            for (int m = 0; m < 4; ++m) { float* rowp = C + (size_t)(row0 + ai * HALF + m * 16) * ldc + col0;
#pragma unroll
                for (int bj = 0; bj < 2; ++bj)
#pragma unroll
                    for (int n = 0; n < 2; ++n) *(f32x4*)(rowp + bj * HALF + n * 16) = acc[ai][bj][m][n] + bv[bj][n]; }
    }
};

template <class Epi, class Sched, bool BKN = false, bool FP8 = false, bool ALIGN_EPI = true>
__device__ __forceinline__ void gemm_phase(LAS unsigned char* lds, const Gemm g, const Sched& S, const Epi& E) {
    const int tid = threadIdx.x, wid = __builtin_amdgcn_readfirstlane(tid >> 6), lane = tid & 63, wr = wid >> 2, wc = wid & 3, fr = lane & 15, fq = lane >> 4;
    const int K = g.K, nt = K / BK;
    unsigned voffB[2]; int RA[2]; unsigned CA2[2];
#pragma unroll
    for (int i = 0; i < 2; ++i) { int R, C; stage_rc(tid * 16 + i * 8192, R, C); const int Rb = Epi::PERM ? ((R & ~31) + perm32(R & 31)) : R;
        RA[i] = R; CA2[i] = (unsigned)C * 2u; voffB[i] = (unsigned)(Rb * K + C) * 2u;
        if constexpr (BKN) { static_assert(!Epi::PERM, "BKN needs PERM == false"); const int q = tid + 512 * i, kr = q >> 4, c16 = q & 15, sw = (kr & 3) | (((kr >> 3) & 1) << 2);
            voffB[i] = (unsigned)(kr * g.N + ((((c16 >> 1) ^ sw) << 4) + ((c16 & 1) << 3))) * 2u; } }
    const size_t kstep = (size_t)(BK * 2);
    const size_t hstep = (size_t)HALF * K * 2;
    const size_t kstepB = BKN ? (size_t)BK * g.N * 2 : kstep, hstepB = BKN ? (size_t)256 : hstep, tstep = BKN ? (size_t)512 : 2 * hstep;
    const unsigned ldsw = (unsigned)wid * 1024u;
    const int aoff = lds_byte(wr * 64 + fr, fq * 8), boff = lds_byte(wc * 32 + fr, fq * 8);
    int btr[2];
    { const int q4 = (lane >> 2) & 3, p4 = lane & 3, sw = q4 | ((fq & 1) << 2);
#pragma unroll
      for (int ns = 0; ns < 2; ++ns) btr[ns] = (int)(uintptr_t)lds + 65536 + (8 * fq + q4) * 256 + ((((wc * 2 + ns) ^ sw)) << 5) + 8 * p4; }
#define PG8_SA(b, h) (((b) * 2 + (h)) * HTB)
#define PG8_SB(b, h) ((4 + (b) * 2 + (h)) * HTB)
#define PG8_STAGE(bufoff, ubase, off32, voff) do { _Pragma("unroll") for (int _i = 0; _i < 2; ++_i) \
        __builtin_amdgcn_global_load_lds((const unsigned*)((const char*)(ubase) + (unsigned)((voff)[_i] + (unsigned)(off32))), (LAS unsigned*)(lds + (bufoff) + ldsw + _i * 8192), 16, 0, 0); } while (0)
#define PG8_STAGEA(bufoff, koff, v0_, v1_) do { \
        __builtin_amdgcn_global_load_lds((const unsigned*)((const char*)g.A + (unsigned)((v0_) + (unsigned)(koff))), (LAS unsigned*)(lds + (bufoff) + ldsw), 16, 0, 0); \
        __builtin_amdgcn_global_load_lds((const unsigned*)((const char*)g.A + (unsigned)((v1_) + (unsigned)(koff))), (LAS unsigned*)(lds + (bufoff) + ldsw + 8192), 16, 0, 0); } while (0)
#define PG8_SETA(v, u) do { _Pragma("unroll") for (int h_ = 0; h_ < 2; ++h_) _Pragma("unroll") for (int i_ = 0; i_ < 2; ++i_) v[h_][i_] = S.a_off(u, h_, RA[i_], K) + CA2[i_]; } while (0)
#define PG8_LDA(dst, b, h) do { _Pragma("unroll") for (int m = 0; m < 4; ++m) _Pragma("unroll") for (int k = 0; k < 2; ++k) dst[m][k] = *(const LAS f16x8*)(lds + PG8_SA(b, h) + aoff + m * 2048 + k * 1024); } while (0)
#define PG8_TRRD(dst, addr, off) asm volatile("ds_read_b64_tr_b16 %0, %1 offset:%2" : "=&v"(dst) : "v"(addr), "i"(off) : "memory")
#define PG8_LDB(dst, b, h) do { if constexpr (BKN) { _Pragma("unroll") for (int n = 0; n < 2; ++n) _Pragma("unroll") for (int k = 0; k < 2; ++k) { s16x4_t lo_, hi_; \
            PG8_TRRD(lo_, btr[n], ((b) * 2 + (h)) * HTB + k * 8192); PG8_TRRD(hi_, btr[n], ((b) * 2 + (h)) * HTB + k * 8192 + 1024); \
            dst[n][k] = __builtin_bit_cast(f16x8, (s16x8_t){lo_[0], lo_[1], lo_[2], lo_[3], hi_[0], hi_[1], hi_[2], hi_[3]}); } } \
        else { _Pragma("unroll") for (int n = 0; n < 2; ++n) _Pragma("unroll") for (int k = 0; k < 2; ++k) dst[n][k] = *(const LAS f16x8*)(lds + PG8_SB(b, h) + boff + n * 2048 + k * 1024); } } while (0)
#define PG8_V8(x0, x1) __builtin_shufflevector(__builtin_bit_cast(v4i_t, x0), __builtin_bit_cast(v4i_t, x1), 0, 1, 2, 3, 4, 5, 6, 7)
#define PG8_MMA(ai, bj, At, Bt) do { __builtin_amdgcn_s_setprio(1); if constexpr (FP8) { _Pragma("unroll") for (int m = 0; m < 4; ++m) _Pragma("unroll") for (int n = 0; n < 2; ++n) \
            asm volatile("v_mfma_scale_f32_16x16x128_f8f6f4 %0, %1, %2, %0, %3, %4 op_sel_hi:[0,0,0]" : "+v"(acc[ai][bj][m][n]) : "v"(PG8_V8(Bt[n][0], Bt[n][1])), "v"(PG8_V8(At[m][0], At[m][1])), "v"(sclW), "v"(sclX)); } \
        else { _Pragma("unroll") for (int m = 0; m < 4; ++m) _Pragma("unroll") for (int n = 0; n < 2; ++n) _Pragma("unroll") for (int k = 0; k < 2; ++k) \
            acc[ai][bj][m][n] = __builtin_amdgcn_mfma_f32_16x16x32_f16(Bt[n][k], At[m][k], acc[ai][bj][m][n], 0, 0, 0); } __builtin_amdgcn_s_setprio(0); } while (0)
#define PG8_WAIT_V(n) asm volatile("s_waitcnt vmcnt(" #n ")" ::: "memory")
#define PG8_WAIT_L(n) asm volatile("s_waitcnt lgkmcnt(" #n ")" ::: "memory")
#define PG8_BAR __builtin_amdgcn_s_barrier()
#define PG8_SCHED __builtin_amdgcn_sched_barrier(0)
    Unit cur, nxt; int ui = 0;
    if (!S.next(0, cur)) return;
    f32x4 acc[2][2][4][2];
#pragma unroll
    for (int a = 0; a < 2; ++a)
#pragma unroll
        for (int b = 0; b < 2; ++b)
#pragma unroll
            for (int m = 0; m < 4; ++m)
#pragma unroll
                for (int n = 0; n < 2; ++n) acc[a][b][m][n] = (f32x4){0.f, 0.f, 0.f, 0.f};
    f16x8 At[4][2], B0[2][2], B1[2][2];
    const int sclW = 0x7A7A7A7A, sclX = 0x7F7F7F7F;
    unsigned vAc[2][2], vAn[2][2];
    PG8_SETA(vAc, cur);
    const char* cB = (const char*)g.Bt + cur.boff + (size_t)cur.pn * tstep;
    S.a_ready(cur);
    PG8_STAGE(PG8_SB(0, 0), cB, 0, voffB); PG8_STAGE(PG8_SB(0, 1), cB, hstepB, voffB); PG8_STAGEA(PG8_SA(0, 0), 0, vAc[0][0], vAc[0][1]); PG8_STAGEA(PG8_SA(0, 1), 0, vAc[1][0], vAc[1][1]);
    if (wr == 1) PG8_BAR;
    PG8_WAIT_V(2); PG8_BAR;
    PG8_STAGE(PG8_SB(1, 0), cB, kstepB, voffB); PG8_STAGEA(PG8_SA(1, 0), kstep, vAc[0][0], vAc[0][1]); PG8_STAGE(PG8_SB(1, 1), cB, hstepB + kstepB, voffB);
    PG8_WAIT_V(6); PG8_BAR;
    for (;;) {
        const bool has_next = S.next(ui + 1, nxt);
        if (has_next) { PG8_SETA(vAn, nxt); }
        else {
#pragma unroll
            for (int h_ = 0; h_ < 2; ++h_)
#pragma unroll
                for (int i_ = 0; i_ < 2; ++i_) vAn[h_][i_] = vAc[h_][i_]; }
        const char* nB = has_next ? (const char*)g.Bt + nxt.boff + (size_t)nxt.pn * tstep : cB;
        for (int t = 0; t < nt; t += 2) {
            const bool last = (t == nt - 2);
            const size_t k1 = (size_t)(t + 1) * kstep, k2 = last ? (size_t)0 : (size_t)(t + 2) * kstep, k3 = k2 + kstep;
            const unsigned w00 = last ? vAn[0][0] : vAc[0][0], w01 = last ? vAn[0][1] : vAc[0][1], w10 = last ? vAn[1][0] : vAc[1][0], w11 = last ? vAn[1][1] : vAc[1][1];
            const char* bb = last ? nB : cB; const unsigned o2 = last ? 0u : (unsigned)((size_t)(t + 2) * kstepB), o3 = o2 + (unsigned)kstepB;
            if (last && has_next) S.a_ready(nxt);
            PG8_LDB(B0, 0, 0); PG8_LDB(B1, 0, 1); PG8_SCHED; PG8_LDA(At, 0, 0); PG8_STAGEA(PG8_SA(1, 1), k1, vAc[1][0], vAc[1][1]);
            PG8_WAIT_V(8); PG8_WAIT_L(0); PG8_SCHED; PG8_BAR; PG8_MMA(0, 0, At, B0); PG8_MMA(0, 1, At, B1); PG8_BAR; PG8_SCHED;
            PG8_LDA(At, 0, 1); PG8_STAGE(PG8_SB(0, 0), bb, o2, voffB); PG8_STAGE(PG8_SB(0, 1), bb, o2 + (unsigned)hstepB, voffB); PG8_STAGEA(PG8_SA(0, 0), k2, w00, w01);
            PG8_WAIT_V(8); PG8_WAIT_L(0); PG8_BAR; PG8_MMA(1, 0, At, B0); PG8_MMA(1, 1, At, B1); PG8_BAR; PG8_SCHED;
            PG8_LDB(B0, 1, 0); PG8_LDB(B1, 1, 1); PG8_SCHED; PG8_LDA(At, 1, 0); PG8_STAGEA(PG8_SA(0, 1), k2, w10, w11);
            PG8_WAIT_V(8); PG8_WAIT_L(0); PG8_SCHED; PG8_BAR; PG8_MMA(0, 0, At, B0); PG8_MMA(0, 1, At, B1); PG8_BAR; PG8_SCHED;
            PG8_LDA(At, 1, 1); PG8_STAGE(PG8_SB(1, 0), bb, o3, voffB); PG8_STAGE(PG8_SB(1, 1), bb, o3 + (unsigned)hstepB, voffB); PG8_STAGEA(PG8_SA(1, 0), k3, w00, w01);
            PG8_WAIT_V(8); PG8_WAIT_L(0); PG8_BAR; PG8_MMA(1, 0, At, B0); PG8_MMA(1, 1, At, B1); PG8_BAR; PG8_SCHED;
        }
        if constexpr (ALIGN_EPI) { if (wr == 0) PG8_BAR; }
        if constexpr (FP8) { asm volatile("s_nop 15\n\ts_nop 15" ::: "memory"); }
        E(acc, cur, wr, wc, fr, fq); S.done(cur);
        if (!has_next) break;
#pragma unroll
        for (int a = 0; a < 2; ++a)
#pragma unroll
            for (int b = 0; b < 2; ++b)
#pragma unroll
                for (int m = 0; m < 4; ++m)
#pragma unroll
                    for (int n = 0; n < 2; ++n) acc[a][b][m][n] = (f32x4){0.f, 0.f, 0.f, 0.f};
        cur = nxt; cB = nB; ++ui;
#pragma unroll
        for (int h_ = 0; h_ < 2; ++h_)
#pragma unroll
            for (int i_ = 0; i_ < 2; ++i_) vAc[h_][i_] = vAn[h_][i_];
        if constexpr (ALIGN_EPI) { if (wr == 1) PG8_BAR; }
    }
    PG8_WAIT_V(0);
    if constexpr (!ALIGN_EPI) { if (wr == 0) PG8_BAR; }
    PG8_BAR;
#undef PG8_SA
#undef PG8_SB
#undef PG8_STAGE
#undef PG8_STAGEA
#undef PG8_SETA
#undef PG8_LDA
#undef PG8_LDB
#undef PG8_TRRD
#undef PG8_MMA
#undef PG8_V8
#undef PG8_WAIT_V
#undef PG8_WAIT_L
#undef PG8_BAR
#undef PG8_SCHED
}
}

__device__ __forceinline__ void transpose_item(const float* W, int K, int N, f16_t* WT, LAS float* scr, int nblk, int item, int lane) {
    const int kb = item / nblk, nb = item % nblk, k0 = 64 * kb, n0 = 64 * nb;
    const int kr = lane >> 4, nq = (lane & 15) * 4;
    const bool ok = (n0 + nq) < N;
    f32x4 v[16];
#pragma unroll
    for (int i = 0; i < 16; ++i) v[i] = ok ? *(const f32x4*)(W + (size_t)(k0 + 4 * i + kr) * N + n0 + nq) : (f32x4){0.f, 0.f, 0.f, 0.f};
#pragma unroll
    for (int i = 0; i < 16; ++i) { LAS float* d = scr + (4 * i + kr) * 65 + nq; d[0] = v[i][0]; d[1] = v[i][1]; d[2] = v[i][2]; d[3] = v[i][3]; }
    asm volatile("s_waitcnt lgkmcnt(0)" ::: "memory");
    const int c = lane & 7;
#pragma unroll
    for (int j = 0; j < 8; ++j) { const int n = (lane >> 3) + 8 * j; const LAS float* sp = scr + (8 * c) * 65 + n;
        u32x4 o; o.x = pk2h(sp[0 * 65], sp[1 * 65]); o.y = pk2h(sp[2 * 65], sp[3 * 65]); o.z = pk2h(sp[4 * 65], sp[5 * 65]); o.w = pk2h(sp[6 * 65], sp[7 * 65]);
        *(u32x4*)(WT + (size_t)(n0 + n) * K + k0 + 8 * c) = o; }
    asm volatile("s_waitcnt lgkmcnt(0)" ::: "memory");
}

__device__ __forceinline__ void transpose_item_q(const float* W, int K, int N, unsigned char* WQ, LAS float* scr, int nblk, int item, int lane, float scale) {
    const int kb = item / nblk, nb = item % nblk, k0 = 128 * kb, n0 = 32 * nb;
    const int kr = lane >> 3, nq = (lane & 7) * 4;
    f32x4 v[16];
#pragma unroll
    for (int i = 0; i < 16; ++i) v[i] = __builtin_nontemporal_load((const f32x4*)(W + (size_t)(k0 + 8 * i + kr) * N + n0 + nq));
#pragma unroll
    for (int i = 0; i < 16; ++i) { LAS float* d = scr + (8 * i + kr) * 33 + nq; d[0] = v[i][0] * scale; d[1] = v[i][1] * scale; d[2] = v[i][2] * scale; d[3] = v[i][3] * scale; }
    asm volatile("s_waitcnt lgkmcnt(0)" ::: "memory");
    const int c = lane & 7;
#pragma unroll
    for (int j = 0; j < 4; ++j) { const int n = (lane >> 3) + 8 * j; const LAS float* sp = scr + (16 * c) * 33 + n;
        u32x4 o; o.x = pk4q(sp[0 * 33], sp[1 * 33], sp[2 * 33], sp[3 * 33]); o.y = pk4q(sp[4 * 33], sp[5 * 33], sp[6 * 33], sp[7 * 33]);
        o.z = pk4q(sp[8 * 33], sp[9 * 33], sp[10 * 33], sp[11 * 33]); o.w = pk4q(sp[12 * 33], sp[13 * 33], sp[14 * 33], sp[15 * 33]);
        *(u32x4*)(WQ + (size_t)(n0 + n) * K + k0 + 16 * c) = o; }
    asm volatile("s_waitcnt lgkmcnt(0)" ::: "memory");
}

__device__ __forceinline__ void tq_issue(f32x4 (&v)[16], const float* W, int N, int k0, int n0, int lane) {
    const int kr = lane >> 3, nq = (lane & 7) * 4;
#pragma unroll
    for (int i = 0; i < 16; ++i) v[i] = __builtin_nontemporal_load((const f32x4*)(W + (size_t)(k0 + 8 * i + kr) * N + n0 + nq));
}
__device__ __forceinline__ void tq_finish(const f32x4 (&v)[16], unsigned char* WQ, int K, int k0, int n0, LAS float* scr, int lane, float scale) {
    const int kr = lane >> 3, nq = (lane & 7) * 4;
#pragma unroll
    for (int i = 0; i < 16; ++i) { LAS float* d = scr + (8 * i + kr) * 33 + (nq ^ (4 * ((i >> 2) & 3))); d[0] = v[i][0] * scale; d[1] = v[i][1] * scale; d[2] = v[i][2] * scale; d[3] = v[i][3] * scale; }
    asm volatile("s_waitcnt lgkmcnt(0)" ::: "memory");
    const int c = lane & 7;
#pragma unroll
    for (int j = 0; j < 4; ++j) { const int n = (lane >> 3) + 8 * j; const LAS float* sp = scr + (16 * c) * 33 + (n ^ (4 * ((c >> 1) & 3)));
        u32x4 o; o.x = pk4q(sp[0 * 33], sp[1 * 33], sp[2 * 33], sp[3 * 33]); o.y = pk4q(sp[4 * 33], sp[5 * 33], sp[6 * 33], sp[7 * 33]);
        o.z = pk4q(sp[8 * 33], sp[9 * 33], sp[10 * 33], sp[11 * 33]); o.w = pk4q(sp[12 * 33], sp[13 * 33], sp[14 * 33], sp[15 * 33]);
        asm volatile("global_store_dwordx4 %0, %1, off sc1 nt\n\ts_nop 1" :: "v"(WQ + (size_t)(n0 + n) * K + k0 + 16 * c), "v"(o) : "memory"); }
    asm volatile("s_waitcnt lgkmcnt(0)" ::: "memory");
}
__device__ __forceinline__ void tq_run16(const float* W, unsigned char* WQ, int K, int N, int n0, LAS float* scr, int lane, float scale) {
    f32x4 va[16], vb[16];
    tq_issue(va, W, N, 0, n0, lane);
#pragma unroll 1
    for (int j = 0; j < 16; j += 2) {
        tq_issue(vb, W, N, 128 * (j + 1), n0, lane);
        tq_finish(va, WQ, K, 128 * j, n0, scr, lane, scale);
        if (j + 2 < 16) tq_issue(va, W, N, 128 * (j + 2), n0, lane);
        tq_finish(vb, WQ, K, 128 * (j + 1), n0, scr, lane, scale);
    }
}

constexpr size_t MiB = 1u << 20;
constexpr size_t WS_CTL = 0, CTL_ZERO_BYTES = 1 * MiB;
constexpr int CW_BAR = 4096;
constexpr int CW_XQ = 12288  ;
constexpr int CW_TQ = 8192, CW_GQ = 8256, CW_RDY0 = 8320  , CW_TMO2 = 10432;
constexpr size_t WS_ADAP = 1 * MiB;
constexpr size_t WS_ADA = 2 * MiB;
constexpr size_t WS_TOPI = 3 * MiB;
constexpr size_t WS_GATE = 4 * MiB;
constexpr size_t WS_LISTS = 5 * MiB;
constexpr size_t WS_COUNTS = 6 * MiB;
constexpr size_t WS_SLOT = 7 * MiB;
constexpr size_t WS_SEL = 8 * MiB;
constexpr size_t WS_H1H = 16 * MiB;
constexpr size_t WS_PROJ = 80 * MiB;
constexpr size_t WS_SCORES = 260 * MiB;
constexpr size_t WS_MERGEDH = 388 * MiB;
constexpr size_t WS_MIX = 452 * MiB;
constexpr size_t WS_X1 = 516 * MiB;
constexpr size_t WS_H2 = 580 * MiB;
constexpr size_t WS_H2H = 644 * MiB;
constexpr size_t WS_WTIN = 676 * MiB;
constexpr size_t WS_WTOUT = 700 * MiB;
constexpr size_t WS_WTGU = 708 * MiB;
constexpr size_t WS_WTDN = 1220 * MiB;
constexpr size_t WS_XG = 1476 * MiB;
constexpr size_t WS_ACTH = 1636 * MiB;
constexpr size_t WS_YROWS = 1796 * MiB;
constexpr size_t WS_QH = 2116 * MiB;
constexpr size_t WS_KH = 2132 * MiB;
constexpr size_t WS_VH = 2136 * MiB;
constexpr size_t WS_QIH = 2140 * MiB;
constexpr size_t WS_KIH = 2156 * MiB;
constexpr size_t WS_WI = 2157 * MiB;
constexpr size_t WS_MASK = 2158 * MiB;
constexpr size_t WS_OPART = 2162 * MiB;
constexpr size_t WS_OSTAT = 2194 * MiB;
constexpr size_t WS_END = 2196 * MiB;
#define DINP 5888
#define PMAX 40960

constexpr int LDS_BYTES = 147456;
constexpr int MISC_OFF = 139264;

struct Args { const void* in[20]; float* out; unsigned char* ws; int ph_lo, ph_hi; };

__device__ __forceinline__ void rope_cs(int pos, float invf, float& c, float& s) {
    const float ang = (float)pos * invf;
    const double rev = (double)ang * 0.15915494309189535;
    const double fr = rev - floor(rev);
    const float f = (float)fr;
    s = __builtin_amdgcn_sinf(f);
    c = __builtin_amdgcn_cosf(f);
}
__device__ __forceinline__ float bsum(float v, float* red) {
    for (int o = 32; o >= 1; o >>= 1) v += __shfl_xor(v, o);
    __syncthreads();
    if ((threadIdx.x & 63) == 0) red[threadIdx.x >> 6] = v;
    __syncthreads();
    return ((red[0] + red[1]) + (red[2] + red[3])) + ((red[4] + red[5]) + (red[6] + red[7]));
}
__device__ __forceinline__ float bmax(float v, float* red) {
    for (int o = 32; o >= 1; o >>= 1) v = fmaxf(v, __shfl_xor(v, o));
    __syncthreads();
    if ((threadIdx.x & 63) == 0) red[threadIdx.x >> 6] = v;
    __syncthreads();
    return fmaxf(fmaxf(fmaxf(red[0], red[1]), fmaxf(red[2], red[3])), fmaxf(fmaxf(red[4], red[5]), fmaxf(red[6], red[7])));
}

__device__ __forceinline__ void nb_ada_part(const float* c, const float* w, float* part, int vb, unsigned char* lds) {
    float* sc = (float*)lds;
    const int jb = vb / ADA_KC, kc = vb % ADA_KC, k0 = kc * (DM / ADA_KC);
    { const int b = threadIdx.x >> 8, k = threadIdx.x & 255; const float v = c[b * DM + k0 + k]; sc[b * 256 + k] = v / (1.0f + expf(-v)); }
    __syncthreads();
    const int j = jb * NT + threadIdx.x;
    float a0 = 0.f, a1 = 0.f;
    for (int k = 0; k < DM / ADA_KC; ++k) { const float wv = w[(size_t)(k0 + k) * (6 * DM) + j]; a0 += sc[k] * wv; a1 += sc[256 + k] * wv; }
    part[((size_t)kc * 2 + 0) * (6 * DM) + j] = a0; part[((size_t)kc * 2 + 1) * (6 * DM) + j] = a1;
    __syncthreads();
}

__device__ __forceinline__ void nb_modnorm(const float* x, const float* g, const float* ada, int sh_off, int sc_off, f16_t* out, int t, unsigned char* lds) {
    float* red = (float*)lds;
    const int bb = t / SEQ; const float* xr = x + (size_t)t * DM;
    float v[4]; float ss = 0.f;
#pragma unroll
    for (int i = 0; i < 4; ++i) { v[i] = xr[threadIdx.x + i * NT]; ss += v[i] * v[i]; }
    ss = bsum(ss, red);
    const float rstd = rsqrtf(ss * (1.0f / DM) + 1e-6f);
#pragma unroll
    for (int i = 0; i < 4; ++i) { const int col = threadIdx.x + i * NT;
        const float hv = v[i] * rstd * g[col] * (1.0f + ada[bb * 6 * DM + sc_off + col]) + ada[bb * 6 * DM + sh_off + col];
        out[(size_t)t * DM + col] = __builtin_bit_cast(unsigned short, (_Float16)hv); }
    __syncthreads();
}

template <int MODE>
__device__ __forceinline__ void nb_sgemm(const float* A, const float* B, const float* bias, float* C, int M, int N, int K, int lda, int ldb, int ldc,
                                         const int* lists, int rowbase, int m0, int n0, unsigned char* lds) {
    float (*As)[132] = (float (*)[132])lds;
    float (*Bs)[68] = (float (*)[68])(lds + 16 * 132 * 4);
    const int tid = threadIdx.x, tx = tid & 15, ty = tid >> 4;
    const int ar = tid >> 2, ak = (tid & 3) * 4;
    const int bk = (tid >> 4) & 15, bn = (tid & 15) * 4;
    const float* arow = nullptr;
    if (m0 + ar < M) {
        if (MODE == 0) arow = A + (size_t)(m0 + ar) * lda;
        else if (MODE == 1) arow = A + (size_t)(lists[m0 + ar] >> 2) * lda;
        else arow = A + (size_t)(rowbase + m0 + ar) * lda;
    }
    const bool bok = (tid < 256) && ((n0 + bn) < N);
    float acc[4][4];
#pragma unroll
    for (int i = 0; i < 4; ++i)
#pragma unroll
        for (int j = 0; j < 4; ++j) acc[i][j] = 0.f;
    for (int k0 = 0; k0 < K; k0 += 16) {
        float4 av = make_float4(0.f, 0.f, 0.f, 0.f), bv = make_float4(0.f, 0.f, 0.f, 0.f);
        if (arow) av = *(const float4*)(arow + k0 + ak);
        if (bok) bv = *(const float4*)(B + (size_t)(k0 + bk) * ldb + n0 + bn);
        __syncthreads();
        As[ak + 0][ar] = av.x; As[ak + 1][ar] = av.y; As[ak + 2][ar] = av.z; As[ak + 3][ar] = av.w;
        if (tid < 256) *(float4*)&Bs[bk][bn] = bv;
        __syncthreads();
#pragma unroll
        for (int kk = 0; kk < 16; ++kk) {
            const float4 a4 = *(const float4*)&As[kk][ty * 4];
            const float4 b4 = *(const float4*)&Bs[kk][tx * 4];
            const float a[4] = {a4.x, a4.y, a4.z, a4.w}, b[4] = {b4.x, b4.y, b4.z, b4.w};
#pragma unroll
            for (int i = 0; i < 4; ++i)
#pragma unroll
                for (int j = 0; j < 4; ++j) acc[i][j] += a[i] * b[j];
        }
    }
#pragma unroll
    for (int i = 0; i < 4; ++i) { const int m = m0 + ty * 4 + i;
        if (m < M) { const size_t crow = (MODE == 0) ? (size_t)m : (size_t)(rowbase + m);
#pragma unroll
            for (int j = 0; j < 4; ++j) { const int n = n0 + tx * 4 + j; if (n < N) C[crow * ldc + n] = acc[i][j] + (bias ? bias[n] : 0.f); } } }
    __syncthreads();
}

__device__ __forceinline__ void nb_rope_conv(float* proj, const int* positions, const float* cw, const float* g, f16_t* merged, f16_t* qh, f16_t* kh, f16_t* vh, f16_t* qih, f16_t* kih, float* wi, int t, unsigned char* lds) {
    float* red = (float*)lds;
    const int pos = positions[t]; float* pr = proj + (size_t)t * DIN;
    for (int i = threadIdx.x; i < (NH + NKV) * 16; i += NT) { const int h = i >> 4, j = i & 15;
        float* p = (h < NH) ? (pr + O_Q + h * HD) : (pr + O_K + (h - NH) * HD);
        float c, s; rope_cs(pos, c_invf16[j], c, s);
        const float x1 = p[j], x2 = p[j + 16]; p[j] = x1 * c - x2 * s; p[j + 16] = x2 * c + x1 * s; }
    for (int i = threadIdx.x; i < (IH + 1) * 8; i += NT) { const int h = i >> 3, j = i & 7;
        float* p = (h < IH) ? (pr + O_QI + h * IDIM) : (pr + O_KI);
        float c, s; rope_cs(pos, c_invf16[2 * j], c, s);
        const float x1 = p[j], x2 = p[j + 8]; p[j] = x1 * c - x2 * s; p[j + 8] = x2 * c + x1 * s; }
    __syncthreads();
    for (int i = threadIdx.x; i < 1024; i += NT) { qh[(size_t)t * 1024 + i] = __builtin_bit_cast(unsigned short, (_Float16)pr[O_Q + i]); qih[(size_t)t * 1024 + i] = __builtin_bit_cast(unsigned short, (_Float16)pr[O_QI + i]); }
    if (threadIdx.x < 256) { kh[(size_t)t * 256 + threadIdx.x] = __builtin_bit_cast(unsigned short, (_Float16)pr[O_K + threadIdx.x]); vh[(size_t)t * 256 + threadIdx.x] = __builtin_bit_cast(unsigned short, (_Float16)pr[O_V + threadIdx.x]); }
    if (threadIdx.x < 64) kih[(size_t)t * 64 + threadIdx.x] = __builtin_bit_cast(unsigned short, (_Float16)pr[O_KI + threadIdx.x]);
    if (threadIdx.x < 16) wi[(size_t)t * 16 + threadIdx.x] = pr[O_WI + threadIdx.x];
    const int tl = t % SEQ;
    float y[2]; float ss = 0.f;
#pragma unroll
    for (int i = 0; i < 2; ++i) { const int c = threadIdx.x + i * NT;
        const float* p0 = proj + (size_t)t * DIN;
        float acc = cw[2 * DCONV + c] * (p0[O_CG + c] * p0[O_U + c]);
        if (tl >= 1) { const float* p1 = p0 - DIN; acc += cw[1 * DCONV + c] * (p1[O_CG + c] * p1[O_U + c]); }
        if (tl >= 2) { const float* p2 = p0 - 2 * DIN; acc += cw[0 * DCONV + c] * (p2[O_CG + c] * p2[O_U + c]); }
        y[i] = p0[O_BG + c] * acc; ss += y[i] * y[i]; }
    ss = bsum(ss, red);
    const float rstd = rsqrtf(ss * (1.0f / DCONV) + 1e-6f);
#pragma unroll
    for (int i = 0; i < 2; ++i) { const int c = threadIdx.x + i * NT; merged[(size_t)t * DM + c] = __builtin_bit_cast(unsigned short, (_Float16)(y[i] * rstd * g[c])); }
    __syncthreads();
}

__device__ __forceinline__ void nb_scores(const float* proj, float* scores, int t, unsigned char* lds) {
    float* qi = (float*)lds; float* w = qi + IH * IDIM;
    const int tl = t % SEQ, t0 = t - tl;
    for (int i = threadIdx.x; i < IH * IDIM; i += NT) qi[i] = proj[(size_t)t * DIN + O_QI + i];
    if (threadIdx.x < IH) w[threadIdx.x] = proj[(size_t)t * DIN + O_WI + threadIdx.x];
    __syncthreads();
    for (int s = threadIdx.x; s <= tl; s += NT) {
        const float* kp = proj + (size_t)(t0 + s) * DIN + O_KI;
        float kr[IDIM];
#pragma unroll
        for (int d = 0; d < IDIM; ++d) kr[d] = kp[d];
        float acc = 0.f;
        for (int h = 0; h < IH; ++h) { float dot = 0.f;
#pragma unroll
            for (int d = 0; d < IDIM; ++d) dot += qi[h * IDIM + d] * kr[d];
            acc += w[h] * fmaxf(dot, 0.f); }
        scores[(size_t)t * SEQ + s] = acc;
    }
    __syncthreads();
}

__device__ __forceinline__ void nb_topk(const float* scores, int* sel, int t, unsigned char* lds) {
    unsigned long long* key = (unsigned long long*)lds;
    const int tl = t % SEQ;
    for (int i = threadIdx.x; i < SEQ; i += NT) {
        unsigned long long kv = 0ull;
        if (i <= tl) { unsigned u = __float_as_uint(scores[(size_t)t * SEQ + i]); u = (u & 0x80000000u) ? ~u : (u | 0x80000000u);
            kv = ((unsigned long long)u << 32) | (unsigned)(0xFFFFFFFFu - (unsigned)i); }
        key[i] = kv; }
    __syncthreads();
    for (int k = 2; k <= SEQ; k <<= 1)
        for (int j = k >> 1; j > 0; j >>= 1) {
            for (int i = threadIdx.x; i < SEQ; i += NT) { const int ixj = i ^ j;
                if (ixj > i) { const unsigned long long a = key[i], b = key[ixj]; const bool desc = ((i & k) == 0);
                    if (desc ? (a < b) : (a > b)) { key[i] = b; key[ixj] = a; } } }
            __syncthreads();
        }
    for (int i = threadIdx.x; i < TOPK; i += NT) { const unsigned long long kv = key[i];
        sel[(size_t)t * TOPK + i] = (kv == 0ull) ? -1 : (int)(0xFFFFFFFFu - (unsigned)(kv & 0xFFFFFFFFull)); }
    __syncthreads();
}

__device__ __forceinline__ void nb_attn(const float* proj, const int* sel, const float* g, f16_t* merged, int t, unsigned char* lds) {
    float* red = (float*)lds; float* q = red + 8; float* p = q + NH * HD; float* y = p + TOPK; int* si = (int*)(y + NH * HD);
    const int tl = t % SEQ, t0 = t - tl, tid = threadIdx.x;
    for (int i = tid; i < NH * HD; i += NT) q[i] = proj[(size_t)t * DIN + O_Q + i];
    if (tid < TOPK) { const int s = sel[(size_t)t * TOPK + tid]; si[tid] = (s >= 0 && s <= tl) ? s : -1; }
    __syncthreads();
    const float scale = 0.08838834764831845f;
    for (int h = 0; h < NH; ++h) { const int gk = h / (NH / NKV);
        const int s = (tid < TOPK) ? si[tid] : -1; float logit = -INFINITY;
        if (s >= 0) { const float* kp = proj + (size_t)(t0 + s) * DIN + O_K + gk * HD; float d = 0.f;
            for (int i = 0; i < HD; ++i) d += q[h * HD + i] * kp[i];
            logit = d * scale; }
        const float mx = bmax(logit, red);
        const float ex = (s >= 0) ? expf(logit - mx) : 0.f;
        const float sum = bsum(ex, red);
        if (tid < TOPK) p[tid] = ex / sum;
        __syncthreads();
        if (tid < HD) { float o = 0.f;
            for (int i = 0; i < TOPK; ++i) { const int s2 = si[i]; if (s2 >= 0) o += p[i] * proj[(size_t)(t0 + s2) * DIN + O_V + gk * HD + tid]; }
            y[h * HD + tid] = o; }
        __syncthreads();
    }
    float ss = 0.f;
#pragma unroll
    for (int i = 0; i < 2; ++i) { const float v = y[tid + i * NT]; ss += v * v; }
    ss = bsum(ss, red);
    const float rstd = rsqrtf(ss * (1.0f / (NH * HD)) + 1e-6f);
#pragma unroll
    for (int i = 0; i < 2; ++i) { const int c = tid + i * NT; merged[(size_t)t * DM + DCONV + c] = __builtin_bit_cast(unsigned short, (_Float16)(y[c] * rstd * g[c])); }
    __syncthreads();
}

__device__ __forceinline__ void nb_post_mix(const float* x, const float* mix, const float* gpost, const float* gpre, const float* ada, float* x1, float* h2, f16_t* h2h, int t, unsigned char* lds) {
    float* red = (float*)lds;
    const int bb = t / SEQ; const float* ad = ada + bb * 6 * DM;
    float m[4], xv[4]; float ss = 0.f;
#pragma unroll
    for (int i = 0; i < 4; ++i) { m[i] = mix[(size_t)t * DM + threadIdx.x + i * NT]; ss += m[i] * m[i]; }
    ss = bsum(ss, red);
    const float r1 = rsqrtf(ss * (1.0f / DM) + 1e-6f);
    float s2 = 0.f;
#pragma unroll
    for (int i = 0; i < 4; ++i) { const int c = threadIdx.x + i * NT; xv[i] = x[(size_t)t * DM + c] + ad[A_GT1 + c] * (m[i] * r1 * gpost[c]); s2 += xv[i] * xv[i]; }
    s2 = bsum(s2, red);
    const float r2 = rsqrtf(s2 * (1.0f / DM) + 1e-6f);
#pragma unroll
    for (int i = 0; i < 4; ++i) { const int c = threadIdx.x + i * NT; x1[(size_t)t * DM + c] = xv[i];
        const float hv = xv[i] * r2 * gpre[c] * (1.0f + ad[A_SC2 + c]) + ad[A_SH2 + c];
        h2[(size_t)t * DM + c] = hv; h2h[(size_t)t * DM + c] = __builtin_bit_cast(unsigned short, (_Float16)hv); }
    __syncthreads();
}

__device__ __forceinline__ void nb_router(const float* h2, const float* wr, const float* br, int* topi, float* gate, int vb, unsigned char* lds) {
    float (*lg)[NE] = (float (*)[NE])lds;
    const int tl = threadIdx.x >> 5, e = threadIdx.x & 31, t = vb * 16 + tl;
    const float* hr = h2 + (size_t)t * DM; float acc = 0.f;
    for (int k = 0; k < DM; ++k) acc += hr[k] * wr[k * NE + e];
    lg[tl][e] = acc + br[e];
    __syncthreads();
    if (e == 0) { float v[NE];
#pragma unroll
        for (int i = 0; i < NE; ++i) v[i] = lg[tl][i];
        int idx[TK]; float val[TK];
#pragma unroll
        for (int k = 0; k < TK; ++k) { float best = -INFINITY; int bi = 0;
#pragma unroll
            for (int i = 0; i < NE; ++i) { const bool take = v[i] > best; best = take ? v[i] : best; bi = take ? i : bi; }
            idx[k] = bi; val[k] = best;
#pragma unroll
            for (int i = 0; i < NE; ++i) v[i] = (i == bi) ? -INFINITY : v[i]; }
        float s = 0.f, ex[TK];
#pragma unroll
        for (int k = 0; k < TK; ++k) { ex[k] = expf(val[k] - val[0]); s += ex[k]; }
#pragma unroll
        for (int k = 0; k < TK; ++k) { topi[t * TK + k] = idx[k]; gate[t * TK + k] = ex[k] / s; } }
    __syncthreads();
}

__device__ __forceinline__ void nb_lists(const int* topi, int* lists, int* counts, int* slotpos, int e) {
    const int lane = threadIdx.x & 63; int base = 0;
    for (int f0 = 0; f0 < NROWS; f0 += 64) { const int f = f0 + lane; const bool m = topi[f] == e;
        const unsigned long long mask = __ballot(m);
        const int pos = base + __popcll(mask & ((1ull << lane) - 1ull));
        if (m) { lists[(size_t)e * NTOK + pos] = f; slotpos[f] = pos; }
        base += __popcll(mask); }
    if (lane == 0) counts[e] = base;
}

__device__ __forceinline__ void nb_final(const float* x1, const float* yrows, const int* topi, const float* gate, const int* counts, const int* slotpos, const float* gpost, const float* ada,
                                         float* out, int t, unsigned char* lds) {
    float* red = (float*)lds; int* row = (int*)(red + 8); float* gw = red + 16;
    const int bb = t / SEQ; const float* ad = ada + bb * 6 * DM;
    if (threadIdx.x < TK) { const int f = t * TK + threadIdx.x, e = topi[f]; int st = 0; for (int i = 0; i < e; ++i) st += ((counts[i] + 255) >> 8) << 8;
        row[threadIdx.x] = st + slotpos[f]; gw[threadIdx.x] = gate[f]; }
    __syncthreads();
    float y[4]; float ss = 0.f;
#pragma unroll
    for (int i = 0; i < 4; ++i) { const int c = threadIdx.x + i * NT; float a = 0.f;
#pragma unroll
        for (int k = 0; k < TK; ++k) a += gw[k] * yrows[(size_t)row[k] * DM + c];
        y[i] = a; ss += a * a; }
    ss = bsum(ss, red);
    const float r = rsqrtf(ss * (1.0f / DM) + 1e-6f);
#pragma unroll
    for (int i = 0; i < 4; ++i) { const int c = threadIdx.x + i * NT; out[(size_t)t * DM + c] = x1[(size_t)t * DM + c] + ad[A_GT2 + c] * (y[i] * r * gpost[c]); }
    __syncthreads();
}


typedef float f32x16 __attribute__((ext_vector_type(16)));
__device__ __forceinline__ void ph_scores_pair(const f16_t* qih, const f16_t* kih, const float* wi, float* scores, int t0, int lane) {
    const int r = lane & 31, hi = lane >> 5, tl0 = t0 % SEQ, tb = t0 - tl0;
    const int arow_q = t0 + ((r >> 2) & 1), arow_h = (r & 3) + 4 * (r >> 3);
    f16x8 aq[4];
#pragma unroll
    for (int kk = 0; kk < 4; ++kk) aq[kk] = *(const f16x8*)(qih + (size_t)arow_q * 1024 + arow_h * 64 + kk * 16 + 8 * hi);
    float w[16];
#pragma unroll
    for (int i = 0; i < 4; ++i) { const f32x4 wv = *(const f32x4*)(wi + (size_t)(t0 + hi) * 16 + 4 * i); w[4 * i] = wv[0]; w[4 * i + 1] = wv[1]; w[4 * i + 2] = wv[2]; w[4 * i + 3] = wv[3]; }
    const int ntile = ((tl0 + 1) >> 5) + 1;
    float* orow = scores + (size_t)(t0 + hi) * SEQ + r;
    const f16_t* kp = kih + (size_t)(tb + r) * 64 + 8 * hi;
    f16x8 bk[4][4];
#define SC_LOAD(slot, kt_) do { const int kc_ = ((kt_) < ntile) ? (kt_) : (ntile - 1); _Pragma("unroll") for (int kk = 0; kk < 4; ++kk) bk[slot][kk] = *(const f16x8*)(kp + (size_t)kc_ * 32 * 64 + kk * 16); } while (0)
#define SC_TILE(slot, kt_) do { if ((kt_) < ntile) { f32x16 acc = {0.f, 0.f, 0.f, 0.f, 0.f, 0.f, 0.f, 0.f, 0.f, 0.f, 0.f, 0.f, 0.f, 0.f, 0.f, 0.f}; \
        _Pragma("unroll") for (int kk = 0; kk < 4; ++kk) acc = __builtin_amdgcn_mfma_f32_32x32x16_f16(aq[kk], bk[slot][kk], acc, 0, 0, 0); \
        float sc = 0.f; _Pragma("unroll") for (int i = 0; i < 16; ++i) sc += w[i] * fmaxf(acc[i], 0.f); \
        orow[(kt_) * 32] = sc; } } while (0)
    SC_LOAD(0, 0); SC_LOAD(1, 1); SC_LOAD(2, 2);
    for (int kt = 0; kt < ntile; kt += 4) {
        SC_LOAD(3, kt + 3); SC_TILE(0, kt);
        SC_LOAD(0, kt + 4); SC_TILE(1, kt + 1);
        SC_LOAD(1, kt + 5); SC_TILE(2, kt + 2);
        SC_LOAD(2, kt + 6); SC_TILE(3, kt + 3);
    }
#undef SC_LOAD
#undef SC_TILE
}


__device__ __forceinline__ void ph_scores_block(const f16_t* qih, const f16_t* kih, const float* wi, float* scores, int tq0, LAS unsigned char* lds) {
    const int tid = threadIdx.x, lane = tid & 63, wv = __builtin_amdgcn_readfirstlane(tid >> 6), r = lane & 31, hi = lane >> 5;
    const int t0 = tq0 + 2 * wv, tl0 = t0 % SEQ, tb = t0 - tl0, tlmax = (tq0 % SEQ) + 15;
    const int arow_q = t0 + ((r >> 2) & 1), arow_h = (r & 3) + 4 * (r >> 3);
    f16x8 aq[4];
#pragma unroll
    for (int kk = 0; kk < 4; ++kk) aq[kk] = *(const f16x8*)(qih + (size_t)arow_q * 1024 + arow_h * 64 + kk * 16 + 8 * hi);
    float w[16];
#pragma unroll
    for (int i = 0; i < 4; ++i) { const f32x4 wvv = *(const f32x4*)(wi + (size_t)(t0 + hi) * 16 + 4 * i); w[4 * i] = wvv[0]; w[4 * i + 1] = wvv[1]; w[4 * i + 2] = wvv[2]; w[4 * i + 3] = wvv[3]; }
    const int nchunk = (tlmax >> 8) + 1;
    float* orow = scores + (size_t)(t0 + hi) * SEQ + r;
    const u32x4* gsrc = (const u32x4*)(kih + (size_t)tb * 64) + tid;
    u32x4 st[4];
#define SCB_WRITE(buf) do { _Pragma("unroll") for (int i = 0; i < 4; ++i) { const int q = tid + 512 * i; *(LAS u32x4*)(lds + (buf) * 36864 + (q >> 3) * 144 + (q & 7) * 16) = st[i]; } } while (0)
#pragma unroll
    for (int i = 0; i < 4; ++i) st[i] = gsrc[512 * i];
    SCB_WRITE(0);
    __syncthreads();
    for (int c = 0; c < nchunk; ++c) {
        if (c + 1 < nchunk) {
#pragma unroll
            for (int i = 0; i < 4; ++i) st[i] = gsrc[(size_t)(c + 1) * 2048 + 512 * i]; }
        const LAS unsigned char* kb = lds + (c & 1) * 36864 + r * 144 + hi * 16;
#pragma unroll
        for (int kt = 0; kt < 8; ++kt) { const int s0 = c * 256 + kt * 32;
            if (s0 <= tl0 + 1) {
                f32x16 acc = {0.f, 0.f, 0.f, 0.f, 0.f, 0.f, 0.f, 0.f, 0.f, 0.f, 0.f, 0.f, 0.f, 0.f, 0.f, 0.f};
#pragma unroll
                for (int kk = 0; kk < 4; ++kk) acc = __builtin_amdgcn_mfma_f32_32x32x16_f16(aq[kk], *(const LAS f16x8*)(kb + kt * 32 * 144 + kk * 32), acc, 0, 0, 0);
                float sc = 0.f;
#pragma unroll
                for (int i = 0; i < 16; ++i) sc += w[i] * fmaxf(acc[i], 0.f);
                orow[s0] = sc; } }
        if (c + 1 < nchunk) SCB_WRITE((c + 1) & 1);
        __syncthreads();
    }
#undef SCB_WRITE
}

__device__ __forceinline__ void ph_select_row(const float* scores, unsigned long long* mask, int t, int lane) {
    const int tl = t % SEQ, n = tl + 1, nj = (n + 63) >> 6;
    const float* srow = scores + (size_t)t * SEQ;
    unsigned key[64];
#pragma unroll
    for (int g16 = 0; g16 < 4; ++g16) {
        if (g16 * 16 < nj) { float sv[16];
#pragma unroll
            for (int jj = 0; jj < 16; ++jj) { const int idx = (g16 * 16 + jj) * 64 + lane; sv[jj] = srow[idx <= tl ? idx : tl]; }
#pragma unroll
            for (int jj = 0; jj < 16; ++jj) { const int idx = (g16 * 16 + jj) * 64 + lane; unsigned u = __float_as_uint(sv[jj]); u = (u & 0x80000000u) ? ~u : (u | 0x80000000u);
                key[g16 * 16 + jj] = (idx <= tl) ? u : 0u; } }
        else {
#pragma unroll
            for (int jj = 0; jj < 16; ++jj) key[g16 * 16 + jj] = 0u; } }
    unsigned long long* mrow = mask + (size_t)t * 64;
    if (n <= TOPK) {
#pragma unroll
        for (int j = 0; j < 64; ++j) { const unsigned long long m = (j < nj) ? __ballot(j * 64 + lane <= tl) : 0ull; if (lane == 0) mrow[j] = m; }
        return;
    }
    unsigned T = 0u; bool exact = false;
    for (int bit = 31; bit >= 0; --bit) { const unsigned cand = T | (1u << bit); int cl = 0;
#pragma unroll
        for (int g16 = 0; g16 < 4; ++g16) if (g16 * 16 < nj) {
#pragma unroll
            for (int jj = 0; jj < 16; ++jj) cl += (key[g16 * 16 + jj] >= cand) ? 1 : 0; }
        cl += __builtin_amdgcn_update_dpp(0, cl, 0xb1, 0xf, 0xf, false);
        cl += __builtin_amdgcn_update_dpp(0, cl, 0x4e, 0xf, 0xf, false);
        cl += __builtin_amdgcn_update_dpp(0, cl, 0x124, 0xf, 0xf, false);
        cl += __builtin_amdgcn_update_dpp(0, cl, 0x128, 0xf, 0xf, false);
        cl += __builtin_amdgcn_update_dpp(0, cl, 0x142, 0xa, 0xf, false);
        cl += __builtin_amdgcn_update_dpp(0, cl, 0x143, 0xc, 0xf, false);
        const int cnt = __builtin_amdgcn_readlane(cl, 63);
        if (cnt >= TOPK) T = cand;
        if (cnt == TOPK) { exact = true; break; } }
    int cgt = 0;
    if (exact) { cgt = TOPK; if (T > 0u) T -= 1u; }
    else {
#pragma unroll
        for (int j = 0; j < 64; ++j) if (j < nj) cgt += __popcll(__ballot(key[j] > T)); }
    int need = TOPK - cgt;
#pragma unroll
    for (int j = 0; j < 64; ++j) { unsigned long long m = 0ull;
        if (j < nj) { unsigned long long eq = __ballot(key[j] == T); const unsigned long long gt = __ballot(key[j] > T);
            int c = __popcll(eq);
            while (c > need) { eq &= ~(1ull << (63 - __clzll((long long)eq))); --c; }
            need -= c; m = gt | eq;
            }
        if (lane == 0) mrow[j] = m; }
}


namespace att {
constexpr int D = 128, QS = 1024, KVS = 256;
constexpr float SCALE = 0.08838834764831845f, THR = 8.f;
constexpr int NW = 8, QBLK = 32, KVBLK = 64, QB = NW * QBLK;
constexpr int SHM_V = KVBLK * D * 2, SHM_K = KVBLK * D * 2;
constexpr int ATT_LDS_BYTES = 2 * SHM_V + 2 * SHM_K + NW * 64 * 4;
typedef short bf16x8 __attribute__((ext_vector_type(8)));
typedef short s16x4 __attribute__((ext_vector_type(4)));
#define ATT_MFMA(a, b, c) __builtin_amdgcn_mfma_f32_32x32x16_f16(__builtin_bit_cast(f16x8, a), __builtin_bit_cast(f16x8, b), c, 0, 0, 0)
#define KSWZ(row, colB) ((row) * 256 + ((colB) ^ (((row) & 7) << 4)))
#define SBAR() __builtin_amdgcn_sched_barrier(0)
__device__ __forceinline__ int v_st(int k, int c) { const int kk = (k & ~0xC) | ((k & 4) << 1) | ((k & 8) >> 1); return ((kk >> 3) * 4 + (c >> 5)) * 512 + ((kk & 7) * 32 + (c & 31)) * 2; }
__device__ __forceinline__ int v_rd_base(int lane) { return ((lane & 3) << 3) | (((lane >> 2) & 3) << 6) | (((lane >> 4) & 1) << 5) | (((lane >> 5) & 1) << 8); }
constexpr int v_rd_off(int d0, int ks, int half) { return d0 * 512 + ks * 4096 + half * 2048; }
__device__ __forceinline__ int crow(int r, int hi) { return (r & 3) + 8 * (r >> 2) + 4 * hi; }
__device__ __forceinline__ unsigned cvtpk(float lo, float hi) { unsigned r; asm volatile("v_cvt_pk_f16_f32 %0, %1, %2" : "=v"(r) : "v"(lo), "v"(hi)); return r; }
__device__ __forceinline__ bf16x8 load8(const f16_t* p) { return *reinterpret_cast<const bf16x8*>(p); }
__device__ __forceinline__ void mask_bits(f32x16& p0, f32x16& p1, unsigned lo, unsigned hiw, int hi) {
    const float NEG = -__builtin_inff();
    const unsigned l = lo >> (4 * hi), h = hiw >> (4 * hi);
#pragma unroll
    for (int r = 0; r < 16; ++r) {
        const int c = (r & 3) + 8 * (r >> 2);
        if (((l >> c) & 1u) == 0u) p0[r] = NEG;
        if (((h >> c) & 1u) == 0u) p1[r] = NEG;
    }
}
__device__ __forceinline__ void partialSM(f32x16& p0, f32x16& p1, float& m_reg, float& mn, float& alpha) {
    float pmax = p0[0]; for (int r = 1; r < 16; ++r) pmax = fmaxf(pmax, p0[r]); for (int r = 0; r < 16; ++r) pmax = fmaxf(pmax, p1[r]);
    { auto rr = __builtin_amdgcn_permlane32_swap(__float_as_uint(pmax), __float_as_uint(pmax), false, false);
      pmax = fmaxf(__uint_as_float(rr[0]), __uint_as_float(rr[1])); }
    constexpr float C2 = 1.4426950408889634f * SCALE;
    if (__builtin_expect(__all((pmax - m_reg) * SCALE <= THR), 1)) { mn = m_reg; alpha = 1.f; }
    else { mn = fmaxf(m_reg, pmax); alpha = __builtin_amdgcn_exp2f((m_reg - mn) * C2); m_reg = mn; }
    const float mnL = -mn * C2;
    for (int r = 0; r < 16; ++r) p0[r] = fmaf(p0[r], C2, mnL); for (int r = 0; r < 16; ++r) p1[r] = fmaf(p1[r], C2, mnL);
    for (int r = 0; r < 16; ++r) p0[r] = __builtin_amdgcn_exp2f(p0[r]);
}
__device__ __forceinline__ void finishSM(f32x16& p0, f32x16& p1, float alpha, float& l_reg, bf16x8& pa0, bf16x8& pa1, bf16x8& pa2, bf16x8& pa3) {
    for (int r = 0; r < 16; ++r) p1[r] = __builtin_amdgcn_exp2f(p1[r]);
    float ps = 0; for (int r = 0; r < 16; ++r) ps += p0[r]; for (int r = 0; r < 16; ++r) ps += p1[r];
    { auto rr = __builtin_amdgcn_permlane32_swap(__float_as_uint(ps), __float_as_uint(ps), false, false);
      ps = __uint_as_float(rr[0]) + __uint_as_float(rr[1]); }
    l_reg = l_reg * alpha + ps;
#define PK4(P, B_, OUT) do { unsigned a0 = cvtpk(P[B_+0], P[B_+1]), a1 = cvtpk(P[B_+2], P[B_+3]);                          \
        unsigned b0 = cvtpk(P[B_+4], P[B_+5]), b1 = cvtpk(P[B_+6], P[B_+7]);                                             \
        auto r0 = __builtin_amdgcn_permlane32_swap(a0, b0, false, false); auto r1 = __builtin_amdgcn_permlane32_swap(a1, b1, false, false); \
        u32x4 w = {r0[0], r1[0], r0[1], r1[1]}; OUT = *reinterpret_cast<bf16x8*>(&w); } while (0)
    PK4(p0, 0, pa0); PK4(p0, 8, pa1); PK4(p1, 0, pa2); PK4(p1, 8, pa3);
#undef PK4
}
template <int KB>
__device__ __forceinline__ void qkt(f32x16& p0, f32x16& p1, const char* K_lds, int r32, int hi, const bf16x8* qr) {
    p0 = f32x16{}; p1 = f32x16{};
    const char* kb[4];
#pragma unroll
    for (int dd = 0; dd < 4; ++dd) kb[dd] = K_lds + KB * SHM_K + KSWZ(r32, (dd * 16 + hi * 8) * 2);
#pragma unroll
    for (int d0 = 0; d0 < 8; ++d0) { const char* a = kb[d0 & 3] + (d0 >> 2) * 128;
        bf16x8 b0 = *reinterpret_cast<const bf16x8*>(a);
        bf16x8 b1 = *reinterpret_cast<const bf16x8*>(a + 32 * 256);
        p0 = ATT_MFMA(b0, qr[d0], p0);
        p1 = ATT_MFMA(b1, qr[d0], p1); }
}
template <int VB>
__device__ __forceinline__ void pv_tile(f32x16* o, int vb0, bf16x8 pa0, bf16x8 pa1, bf16x8 pa2, bf16x8 pa3) {
#define TRRD(dst, off) asm volatile("ds_read_b64_tr_b16 %0, %1 offset:%2" : "=&v"(dst) : "v"(vb0), "i"(off) : "memory")
#define PV_D0(d0) do { s16x4 l0, l1, l2, l3, h0, h1, h2, h3; constexpr int b_ = VB * SHM_V + v_rd_off(d0, 0, 0); \
        TRRD(l0, b_); TRRD(h0, b_ + 2048); TRRD(l1, b_ + 4096); TRRD(h1, b_ + 6144); TRRD(l2, b_ + 8192); TRRD(h2, b_ + 10240); TRRD(l3, b_ + 12288); TRRD(h3, b_ + 14336); \
        asm volatile("s_waitcnt lgkmcnt(0)" ::: "memory"); SBAR();   \
        o[d0] = ATT_MFMA(pa0, ((bf16x8){l0[0], l0[1], l0[2], l0[3], h0[0], h0[1], h0[2], h0[3]}), o[d0]);   \
        o[d0] = ATT_MFMA(pa1, ((bf16x8){l1[0], l1[1], l1[2], l1[3], h1[0], h1[1], h1[2], h1[3]}), o[d0]);   \
        o[d0] = ATT_MFMA(pa2, ((bf16x8){l2[0], l2[1], l2[2], l2[3], h2[0], h2[1], h2[2], h2[3]}), o[d0]);   \
        o[d0] = ATT_MFMA(pa3, ((bf16x8){l3[0], l3[1], l3[2], l3[3], h3[0], h3[1], h3[2], h3[3]}), o[d0]); } while (0)
    PV_D0(0); PV_D0(1); PV_D0(2); PV_D0(3);
#undef PV_D0
#undef TRRD
}

struct BlockRef { const f16_t* Q; const f16_t* K; const f16_t* V; const unsigned long long* M; f16_t* O; float* ST; int j_lo, j_hi; };
struct Seam { bf16x8 qr[8]; bf16x8 st_v0, st_v1, st_k0, st_k1; };
#define ROWOFF(k0, rr) ((unsigned)((((k0) + (rr)) * KVS + sc) * 2))
#define LD8(base, off) (*reinterpret_cast<const bf16x8*>((const char*)(base) + (off)))
#define VMW() asm volatile("s_waitcnt vmcnt(0)" ::: "memory")
#define VMWN(n) asm volatile("s_waitcnt vmcnt(%0)" :: "i"(n) : "memory")
#define SLOAD_H(Kp, Vp, k0) do { S.st_v0 = LD8(Vp, ROWOFF(k0, sr)); S.st_v1 = LD8(Vp, ROWOFF(k0, 32 + sr));              \
                         S.st_k0 = LD8(Kp, ROWOFF(k0, sr)); S.st_k1 = LD8(Kp, ROWOFF(k0, 32 + sr)); } while (0)
#define SWRITE_HK(bf) do { *(bf16x8*)(K_lds + (bf) * SHM_K + kws) = S.st_k0; *(bf16x8*)(K_lds + (bf) * SHM_K + kws + 32 * 256) = S.st_k1; } while (0)
#define SWRITE_HV(bf) do { *(bf16x8*)(V_lds + (bf) * SHM_V + vst0) = S.st_v0; *(bf16x8*)(V_lds + (bf) * SHM_V + vst1) = S.st_v1; } while (0)
#define SWRITE_H(bf) do { SWRITE_HV(bf); SWRITE_HK(bf); } while (0)
__device__ __forceinline__ void attn_block(const BlockRef& cur, char* lds) {
    const int tid = threadIdx.x, wid = __builtin_amdgcn_readfirstlane(tid >> 6), lane = tid & 63, r32 = lane & 31, hi = lane >> 5;
    const int j_lo = cur.j_lo, NTL = cur.j_hi - cur.j_lo;
    char* V_lds = lds; char* K_lds = lds + 2 * SHM_V;
    float* ws = (float*)(lds + 2 * SHM_V + 2 * SHM_K) + wid * 64; float* li_l = ws, * al_l = ws + 32;
    float m_reg = -1e30f, l_reg = 0; f32x16 o[4] = {};
    const int sr = tid >> 4, sc = (tid & 15) * 8, vst0 = v_st(sr, sc), vst1 = v_st(32 + sr, sc), kws = KSWZ(sr, sc * 2);
    const int vb0 = (int)(uintptr_t)V_lds + v_rd_base(lane);
    const f16_t* Kh = cur.K; const f16_t* Vh = cur.V;
    Seam S;
#define MROW(t_) (*(const unsigned long long*)((const char*)cur.M + (unsigned)((((wid * QBLK + r32) * 64) + j_lo + (t_)) * 8)))
#define RESC(a) do { if (__any((a) < 1.f)) { if (hi == 0) al_l[r32] = (a); asm volatile("s_waitcnt lgkmcnt(0)" ::: "memory");              \
                     for (int d_ = 0; d_ < 4; ++d_) for (int r = 0; r < 16; ++r) o[d_][r] *= al_l[crow(r, hi)]; } } while (0)
#define KBASE(t) ((j_lo + (t)) * KVBLK)
#define MASKW(P0_, P1_, mw_) mask_bits(P0_, P1_, (unsigned)(mw_), (unsigned)((mw_) >> 32), hi)
#pragma unroll
    for (int d0 = 0; d0 < 8; ++d0) S.qr[d0] = *reinterpret_cast<const bf16x8*>((const char*)cur.Q + (unsigned)(((wid * QBLK + r32) * QS + d0 * 16 + hi * 8) * 2));
    SLOAD_H(Kh, Vh, KBASE(0)); VMW(); SWRITE_H(0);
    __syncthreads();
    f32x16 p0, p1; float mn, al; bf16x8 pa0, pa1, pa2, pa3; unsigned long long mw;
#define STEP(t, CB, NBUF) do {                                                                                                \
        mw = MROW(t); SBAR();                                                                                                 \
        if ((t) + 1 < NTL) { SLOAD_H(Kh, Vh, KBASE((t) + 1)); SBAR(); }                                                       \
        qkt<CB>(p0, p1, K_lds, r32, hi, S.qr);                                                                                \
        MASKW(p0, p1, mw); partialSM(p0, p1, m_reg, mn, al); finishSM(p0, p1, al, l_reg, pa0, pa1, pa2, pa3);                 \
        RESC(al); SBAR();                                                                                                     \
        pv_tile<CB>(o, vb0, pa0, pa1, pa2, pa3);                                                                              \
        if ((t) + 1 < NTL) { VMW(); SWRITE_H(NBUF); }                                                                         \
        __syncthreads(); } while (0)
    for (int t = 0; t < NTL; t += 2) { STEP(t, 0, 1); STEP(t + 1, 1, 0); }
    if (hi == 0) { li_l[r32] = l_reg; *(float2*)(cur.ST + (size_t)(wid * QBLK + r32) * 16) = make_float2(m_reg, l_reg); }
    asm volatile("s_waitcnt lgkmcnt(0)" ::: "memory");
    float rli[16];
#pragma unroll
    for (int r = 0; r < 16; ++r) { const float lv = li_l[crow(r, hi)]; rli[r] = lv > 0.f ? __builtin_amdgcn_rcpf(lv) : 0.f; }
    f16_t* Ow = cur.O + (size_t)(wid * QBLK) * QS;
#pragma unroll
    for (int r = 0; r < 16; ++r) { const int orow = crow(r, hi);
#pragma unroll
        for (int d0 = 0; d0 < 4; ++d0) { const float v = o[d0][r] * rli[r];
            const float vn = __shfl_xor(v, 1);
            if ((r32 & 1) == 0) *(unsigned*)(Ow + (size_t)orow * QS + d0 * 32 + r32) = cvtpk(v, vn); } }
    __syncthreads();
#undef RESC
#undef KBASE
#undef MROW
#undef MASKW
#undef STEP
}
#undef ROWOFF
#undef LD8
#undef VMW
#undef VMWN
#undef SLOAD_H
#undef SWRITE_HK
#undef SWRITE_HV
#undef SWRITE_H
#undef KSWZ
#undef SBAR
}

__device__ __forceinline__ float wsum_dpp(float v) {
    int x = __float_as_int(v);
#define WS_STEP(ctrl, rmask) x = __float_as_int(__int_as_float(x) + __int_as_float(__builtin_amdgcn_update_dpp(0, x, ctrl, rmask, 0xf, false)))
    WS_STEP(0xb1, 0xf); WS_STEP(0x4e, 0xf); WS_STEP(0x124, 0xf); WS_STEP(0x128, 0xf); WS_STEP(0x142, 0xa); WS_STEP(0x143, 0xc);
#undef WS_STEP
    return __int_as_float(__builtin_amdgcn_readlane(x, 63));
}
__device__ __forceinline__ att::BlockRef att_ref(int idx, const f16_t* qh, const f16_t* kh, const f16_t* vh, const unsigned long long* maskp, f16_t* opart, float* ostat) {
    const int item = idx >> 1, which = idx & 1;
    const int bh = item >> 4, b = bh >> 3, h = bh & 7, r = item & 15, p = r >> 1, s = r & 1;
    const int qb = which ? 15 - p : p;
    const int tok0 = b * SEQ + qb * 256, g = h >> 2;
    att::BlockRef R;
    R.Q = qh + (size_t)tok0 * 1024 + h * 128;
    R.K = kh + (size_t)(b * SEQ) * 256 + g * 128;
    R.V = vh + (size_t)(b * SEQ) * 256 + g * 128;
    R.M = maskp + (size_t)tok0 * 64;
    R.O = opart + ((size_t)s * NTOK + tok0) * 1024 + h * 128;
    R.ST = ostat + (((size_t)s * NTOK + tok0) * 8 + h) * 2;
    R.j_lo = s ? 2 * (qb + 1) : 0; R.j_hi = s ? 4 * (qb + 1) : 2 * (qb + 1);
    return R;
}
__device__ __forceinline__ void ph_merge_rows4(const f16_t* opart, const float* ostat, const float* g, f16_t* merged, int t0, int tstride, int lane) {
    const int h = lane >> 3; constexpr float C2 = 1.4426950408889634f * att::SCALE;
    float gv[16];
#pragma unroll
    for (int i = 0; i < 4; ++i) { const f32x4 q = *(const f32x4*)(g + 16 * lane + 4 * i); gv[4 * i] = q[0]; gv[4 * i + 1] = q[1]; gv[4 * i + 2] = q[2]; gv[4 * i + 3] = q[3]; }
    float2 s0[4], s1[4]; f16x8 u[4][2], v[4][2];
#pragma unroll
    for (int r = 0; r < 4; ++r) { const int t = t0 + r * tstride;
        s0[r] = *(const float2*)(ostat + ((size_t)t * 8 + h) * 2); s1[r] = *(const float2*)(ostat + (((size_t)NTOK + t) * 8 + h) * 2);
        const f16x8* p0 = (const f16x8*)(opart + (size_t)t * 1024 + 16 * lane); const f16x8* p1 = (const f16x8*)(opart + ((size_t)NTOK + t) * 1024 + 16 * lane);
        u[r][0] = p0[0]; u[r][1] = p0[1]; v[r][0] = p1[0]; v[r][1] = p1[1]; }
#pragma unroll
    for (int r = 0; r < 4; ++r) { const int t = t0 + r * tstride;
        const float M = fmaxf(s0[r].x, s1[r].x);
        float a0 = s0[r].y * __builtin_amdgcn_exp2f((s0[r].x - M) * C2), a1 = s1[r].y * __builtin_amdgcn_exp2f((s1[r].x - M) * C2);
        const float inv = 1.0f / (a0 + a1); a0 *= inv; a1 *= inv;
        float y[16]; float ss = 0.f;
#pragma unroll
        for (int q = 0; q < 2; ++q)
#pragma unroll
            for (int i = 0; i < 8; ++i) { const float yy = a0 * (float)u[r][q][i] + a1 * (float)v[r][q][i]; y[q * 8 + i] = yy; ss += yy * yy; }
        const float rstd = rsqrtf(wsum_dpp(ss) * (1.0f / 1024.0f) + 1e-6f);
        u32x4 w0, w1;
        w0.x = pk2h(y[0] * rstd * gv[0], y[1] * rstd * gv[1]); w0.y = pk2h(y[2] * rstd * gv[2], y[3] * rstd * gv[3]); w0.z = pk2h(y[4] * rstd * gv[4], y[5] * rstd * gv[5]); w0.w = pk2h(y[6] * rstd * gv[6], y[7] * rstd * gv[7]);
        w1.x = pk2h(y[8] * rstd * gv[8], y[9] * rstd * gv[9]); w1.y = pk2h(y[10] * rstd * gv[10], y[11] * rstd * gv[11]); w1.z = pk2h(y[12] * rstd * gv[12], y[13] * rstd * gv[13]); w1.w = pk2h(y[14] * rstd * gv[14], y[15] * rstd * gv[15]);
        u32x4* dst = (u32x4*)(merged + (size_t)t * DM + DCONV + 16 * lane); dst[0] = w0; dst[1] = w1; }
}

__device__ __forceinline__ float wsum(float v) { return wsum_dpp(v); }
__device__ __forceinline__ void ph_h1_row(const float* x, const LAS float* tab, f16_t* out, int t, int lane) {
    const f32x4* xr = (const f32x4*)(x + (size_t)t * DM) + lane;
    f32x4 v[8]; float ss = 0.f;
#pragma unroll
    for (int j = 0; j < 8; ++j) { v[j] = xr[64 * j]; ss += (v[j][0] * v[j][0] + v[j][1] * v[j][1]) + (v[j][2] * v[j][2] + v[j][3] * v[j][3]); }
    const float rstd = rsqrtf(wsum(ss) * (1.0f / DM) + 1e-6f);
    const LAS f32x4* ta = (const LAS f32x4*)(tab + (t / SEQ) * 2 * DM) + lane; const LAS f32x4* tb = ta + DM / 4;
    u32x2* o = (u32x2*)(out + (size_t)t * DM) + lane;
#pragma unroll
    for (int j = 0; j < 8; ++j) { const f32x4 a = ta[64 * j], b = tb[64 * j]; const f32x4 h = v[j] * rstd * a + b;
        u32x2 w; w.x = pk2h(h[0], h[1]); w.y = pk2h(h[2], h[3]); o[64 * j] = w; }
}
__device__ __forceinline__ void rope32_chunk(float (&v)[16], int chunk, const float (&cs)[16], const float (&sn)[16]) {
#pragma unroll
    for (int j = 0; j < 16; ++j) { const float other = __shfl_xor(v[j], 1);
        if (chunk == 0) v[j] = v[j] * cs[j] - other * sn[j];
        else if (chunk == 1) v[j] = v[j] * cs[j] + other * sn[j]; }
}
__device__ __forceinline__ void ld16(const float* p, float (&v)[16]) {
#pragma unroll
    for (int i = 0; i < 4; ++i) { const f32x4 q = *(const f32x4*)(p + 4 * i); v[4 * i] = q[0]; v[4 * i + 1] = q[1]; v[4 * i + 2] = q[2]; v[4 * i + 3] = q[3]; }
}
__device__ __forceinline__ void ld16(const f16_t* p, float (&v)[16]) {
    const f16x8 a = ((const f16x8*)p)[0], b = ((const f16x8*)p)[1];
#pragma unroll
    for (int i = 0; i < 8; ++i) { v[i] = (float)a[i]; v[8 + i] = (float)b[i]; }
}
__device__ __forceinline__ void st16h(f16_t* p, const float (&v)[16]) {
    u32x4 a, b; a.x = pk2h(v[0], v[1]); a.y = pk2h(v[2], v[3]); a.z = pk2h(v[4], v[5]); a.w = pk2h(v[6], v[7]);
    b.x = pk2h(v[8], v[9]); b.y = pk2h(v[10], v[11]); b.z = pk2h(v[12], v[13]); b.w = pk2h(v[14], v[15]);
    ((u32x4*)p)[0] = a; ((u32x4*)p)[1] = b;
}
__device__ __forceinline__ void ph_rope_conv_row(const f16_t* proj, const int* positions, const float* cw, const float* g, f16_t* merged, f16_t* qh, f16_t* kh, f16_t* vh, f16_t* qih, f16_t* kih, float* wi, int t, int lane) {
    const f16_t* pr = proj + (size_t)t * DIN; const int pos = positions[t];
    float cmine, smine; rope_cs(pos, c_invf16[lane & 15], cmine, smine);
    float cs[16], sn[16];
#pragma unroll
    for (int j = 0; j < 16; ++j) { cs[j] = __shfl(cmine, j); sn[j] = __shfl(smine, j); }
    float v[16];
    ld16(pr + O_Q + 16 * lane, v); rope32_chunk(v, lane & 7, cs, sn); st16h(qh + (size_t)t * 1024 + 16 * lane, v);
    { const int l2 = lane & 15; ld16(pr + ((lane < 16) ? O_K : O_V) + 16 * l2, v); rope32_chunk(v, (lane < 16) ? (lane & 7) : 2, cs, sn);
      if (lane < 32) st16h(((lane < 16) ? kh : vh) + (size_t)t * 256 + 16 * l2, v); }
    ld16(pr + O_QI + 16 * lane, v);
    if ((lane & 3) == 0) {
#pragma unroll
        for (int j = 0; j < 8; ++j) { const float a = v[j], b = v[j + 8]; v[j] = a * cs[2 * j] - b * sn[2 * j]; v[j + 8] = b * cs[2 * j] + a * sn[2 * j]; } }
    st16h(qih + (size_t)t * 1024 + 16 * lane, v);
    ld16(pr + ((lane < 4) ? (O_KI + 16 * lane) : O_WI), v);
    if (lane == 0) {
#pragma unroll
        for (int j = 0; j < 8; ++j) { const float a = v[j], b = v[j + 8]; v[j] = a * cs[2 * j] - b * sn[2 * j]; v[j + 8] = b * cs[2 * j] + a * sn[2 * j]; } }
    if (lane < 4) st16h(kih + (size_t)t * 64 + 16 * lane, v);
    if (lane == 4) {
#pragma unroll
        for (int i = 0; i < 4; ++i) *(f32x4*)(wi + (size_t)t * 16 + 4 * i) = (f32x4){v[4 * i], v[4 * i + 1], v[4 * i + 2], v[4 * i + 3]}; }
    const int tl = t % SEQ, c0 = 16 * lane;
    float cg[16], u[16], y[16];
    ld16(pr + O_CG + c0, cg); ld16(pr + O_U + c0, u); ld16(cw + 2 * DCONV + c0, v);
#pragma unroll
    for (int i = 0; i < 16; ++i) y[i] = v[i] * (cg[i] * u[i]);
    if (tl >= 1) { ld16(pr - DIN + O_CG + c0, cg); ld16(pr - DIN + O_U + c0, u); ld16(cw + 1 * DCONV + c0, v);
#pragma unroll
        for (int i = 0; i < 16; ++i) y[i] += v[i] * (cg[i] * u[i]); }
    if (tl >= 2) { ld16(pr - 2 * DIN + O_CG + c0, cg); ld16(pr - 2 * DIN + O_U + c0, u); ld16(cw + c0, v);
#pragma unroll
        for (int i = 0; i < 16; ++i) y[i] += v[i] * (cg[i] * u[i]); }
    ld16(pr + O_BG + c0, v); float ss = 0.f;
#pragma unroll
    for (int i = 0; i < 16; ++i) { y[i] *= v[i]; ss += y[i] * y[i]; }
    const float rstd = rsqrtf(wsum(ss) * (1.0f / DCONV) + 1e-6f);
    ld16(g + c0, v);
#pragma unroll
    for (int i = 0; i < 16; ++i) y[i] = y[i] * rstd * v[i];
    st16h(merged + (size_t)t * DM + c0, y);
}
__device__ __forceinline__ void ph_post_row(const float* x, const float* mix, const LAS float* tab, float* x1, float* h2, unsigned char* h2q, int t, int lane) {
    const f32x4* mr = (const f32x4*)(mix + (size_t)t * DM) + lane; const f32x4* xr = (const f32x4*)(x + (size_t)t * DM) + lane;
    const LAS f32x4* t0 = (const LAS f32x4*)tab + lane;
    f32x4 m[8]; float ss = 0.f;
#pragma unroll
    for (int j = 0; j < 8; ++j) { m[j] = mr[64 * j]; ss += (m[j][0] * m[j][0] + m[j][1] * m[j][1]) + (m[j][2] * m[j][2] + m[j][3] * m[j][3]); }
    const float r1 = rsqrtf(wsum(ss) * (1.0f / DM) + 1e-6f);
    float s2 = 0.f;
#pragma unroll
    for (int j = 0; j < 8; ++j) { m[j] = xr[64 * j] + t0[64 * j] * (m[j] * r1 * t0[64 * j + DM / 4]); s2 += (m[j][0] * m[j][0] + m[j][1] * m[j][1]) + (m[j][2] * m[j][2] + m[j][3] * m[j][3]); }
    const float r2 = rsqrtf(wsum(s2) * (1.0f / DM) + 1e-6f);
    f32x4* xo = (f32x4*)(x1 + (size_t)t * DM) + lane; f32x4* ho = (f32x4*)(h2 + (size_t)t * DM) + lane; unsigned* hq = (unsigned*)(h2q + (size_t)t * DM) + lane;
#pragma unroll
    for (int j = 0; j < 8; ++j) { xo[64 * j] = m[j]; const f32x4 h = m[j] * r2 * t0[64 * j + 2 * (DM / 4)] + t0[64 * j + 3 * (DM / 4)]; ho[64 * j] = h;
        hq[64 * j] = pk4q(h[0], h[1], h[2], h[3]); }
}
__device__ __forceinline__ void ph_final_row(const float* x1, const f16_t* yrows, const int* topi, const float* gate, const int* slotpos, const LAS int* pst, const LAS float* tab, float* out, int t, int lane) {
    int rows[TK]; float gw_[TK];
#pragma unroll
    for (int k = 0; k < TK; ++k) { const int f = t * TK + k; rows[k] = pst[topi[f]] + slotpos[f]; gw_[k] = gate[f]; }
    float y[4][8]; float ss = 0.f;
#pragma unroll
    for (int j = 0; j < 4; ++j) {
#pragma unroll
        for (int i = 0; i < 8; ++i) y[j][i] = 0.f;
#pragma unroll
        for (int k = 0; k < TK; ++k) { const f16x8 r = *(const f16x8*)(yrows + (size_t)rows[k] * DM + 8 * lane + 512 * j);
#pragma unroll
            for (int i = 0; i < 8; ++i) y[j][i] += gw_[k] * (float)r[i]; }
#pragma unroll
        for (int i = 0; i < 8; ++i) ss += y[j][i] * y[j][i]; }
    const float r = rsqrtf(wsum(ss) * (1.0f / DM) + 1e-6f);
    const LAS float* tg = tab + (t / SEQ) * 2 * DM;
#pragma unroll
    for (int j = 0; j < 4; ++j) { const int col = 8 * lane + 512 * j;
#pragma unroll
        for (int q = 0; q < 2; ++q) { const f32x4 xv = *(const f32x4*)(x1 + (size_t)t * DM + col + 4 * q);
            const f32x4 g2 = *(const LAS f32x4*)(tg + col + 4 * q), gp = *(const LAS f32x4*)(tg + DM + col + 4 * q);
            f32x4 yv = (f32x4){y[j][4 * q], y[j][4 * q + 1], y[j][4 * q + 2], y[j][4 * q + 3]};
            *(f32x4*)(out + (size_t)t * DM + col + 4 * q) = xv + g2 * (yv * r * gp); } }
}
__device__ __forceinline__ void ph_router_mfma(const float* h2, const float* wr, LAS float* part, int tok0, int wv, int lane) {
    const int i = lane & 31, kk = lane >> 5, kb = 256 * wv + 128 * kk;
    const f32x4* ap = (const f32x4*)(h2 + (size_t)(tok0 + i) * DM + kb);
    const float* bp = wr + (size_t)kb * NE + i;
    f32x16 acc = {0.f, 0.f, 0.f, 0.f, 0.f, 0.f, 0.f, 0.f, 0.f, 0.f, 0.f, 0.f, 0.f, 0.f, 0.f, 0.f};
#pragma unroll 4
    for (int s4 = 0; s4 < 32; ++s4) { const f32x4 a = ap[s4];
#pragma unroll
        for (int u = 0; u < 4; ++u) acc = __builtin_amdgcn_mfma_f32_32x32x2f32(a[u], bp[(size_t)(4 * s4 + u) * NE], acc, 0, 0, 0); }
#pragma unroll
    for (int r = 0; r < 16; ++r) part[(wv * 32 + ((r & 3) + 8 * (r >> 2) + 4 * kk)) * 32 + i] = acc[r];
}

constexpr int N_PHASES = 12;
__global__ void __launch_bounds__(NT, 2) fwd(Args args) {
    extern __shared__ __attribute__((aligned(16))) unsigned char lds[];
    volatile LAS unsigned* MISC = (volatile LAS unsigned*)((LAS unsigned char*)lds + MISC_OFF);
    for (int u = threadIdx.x; u < (LDS_BYTES - MISC_OFF) / 4; u += NT) MISC[u] = 0u;
    __syncthreads();
    { XcdBarrier b0 = xcd_barrier_post((unsigned*)(args.ws + WS_CTL) + CW_BAR, MISC + 8); (void)b0; }
    if (threadIdx.x == 0) { MISC[16] = (unsigned)args.ph_lo; MISC[17] = (unsigned)args.ph_hi; MISC[18] = gridDim.x; }
    const int bx = blockIdx.x;
#define LO ((int)__builtin_amdgcn_readfirstlane((int)((LAS unsigned*)((LAS unsigned char*)lds + MISC_OFF))[16]))
#define HI ((int)__builtin_amdgcn_readfirstlane((int)((LAS unsigned*)((LAS unsigned char*)lds + MISC_OFF))[17]))
#define G ((int)__builtin_amdgcn_readfirstlane((int)((LAS unsigned*)((LAS unsigned char*)lds + MISC_OFF))[18]))
#ifndef REP_PHASE
#define REP_PHASE -1
#endif
#define IN(k) (LO <= (k) && (k) < HI)
#define PHASE(k) if (IN(k)) for (int rep_ = 0; rep_ < (((k) == REP_PHASE) ? 2 : 1); ++rep_)
#define SEAM(k) do { if (IN(k) && IN((k) + 1)) { XcdBarrier bar_; bar_.bar = (unsigned*)WSP(WS_CTL) + CW_BAR; bar_.x = xb_xcc_id(); bar_.st = MISC + 8; xcd_barrier(bar_); } } while (0)

    LAS unsigned long long* PT = (LAS unsigned long long*)((LAS unsigned char*)lds + MISC_OFF + 256);
#pragma unroll
    for (int k = 0; k < 20; ++k) if (threadIdx.x == k) PT[k] = (unsigned long long)args.in[k];
    if (threadIdx.x == 20) PT[20] = (unsigned long long)args.out;
    if (threadIdx.x == 21) PT[21] = (unsigned long long)args.ws;
    __syncthreads();
#define GASP __attribute__((address_space(1)))
#define LDP(k) ((unsigned char*)(GASP unsigned char*)(((unsigned long long)(unsigned)__builtin_amdgcn_readfirstlane((int)(unsigned)(PT[k] >> 32)) << 32) | (unsigned long long)(unsigned)__builtin_amdgcn_readfirstlane((int)(unsigned)PT[k])))
#define WSP(off) (LDP(21) + (off))
#define p_x ((const float*)LDP(0))
#define p_c ((const float*)LDP(1))
#define p_positions ((const int*)LDP(2))
#define p_w_ada ((const float*)LDP(3))
#define p_b_ada ((const float*)LDP(4))
#define p_g_pre_mix ((const float*)LDP(5))
#define p_g_post_mix ((const float*)LDP(6))
#define p_w_in ((const float*)LDP(7))
#define p_conv_w ((const float*)LDP(8))
#define p_g_conv_out ((const float*)LDP(9))
#define p_g_attn_out ((const float*)LDP(10))
#define p_w_out ((const float*)LDP(11))
#define p_g_pre_ffn ((const float*)LDP(12))
#define p_g_post_ffn ((const float*)LDP(13))
#define p_w_router ((const float*)LDP(14))
#define p_b_router ((const float*)LDP(15))
#define p_w_gate_up ((const float*)LDP(16))
#define p_b_gate_up ((const float*)LDP(17))
#define p_w_down ((const float*)LDP(18))
#define p_b_down ((const float*)LDP(19))
#define p_out ((float*)LDP(20))
#define p_adap ((float*)WSP(WS_ADAP))
#define p_ada ((float*)WSP(WS_ADA))
#define p_topi ((int*)WSP(WS_TOPI))
#define p_gate ((float*)WSP(WS_GATE))
#define p_lists ((int*)WSP(WS_LISTS))
#define p_counts ((int*)WSP(WS_CTL) + 2048)
#define p_slotpos ((int*)WSP(WS_SLOT))
#define p_tile_e ((int*)WSP(WS_COUNTS + 1024))
#define p_ntiles_p ((int*)WSP(WS_COUNTS + 2048))
#define p_sel ((int*)WSP(WS_SEL))
#define p_proj ((f16_t*)WSP(WS_PROJ))
#define p_scores ((float*)WSP(WS_SCORES))
#define p_mix ((float*)WSP(WS_MIX))
#define p_x1 ((float*)WSP(WS_X1))
#define p_h2 ((float*)WSP(WS_H2))
#define p_yrows ((f16_t*)WSP(WS_YROWS))
#define p_wtin ((f16_t*)WSP(WS_WTIN))
#define p_wtout ((f16_t*)WSP(WS_WTOUT))
#define p_wtgu ((f16_t*)WSP(WS_WTGU))
#define p_wtdn ((f16_t*)WSP(WS_WTDN))
#define p_h1h ((f16_t*)WSP(WS_H1H))
#define p_mergedh ((f16_t*)WSP(WS_MERGEDH))
#define p_h2h ((f16_t*)WSP(WS_H2H))
#define p_xg ((f16_t*)WSP(WS_XG))
#define p_acth ((f16_t*)WSP(WS_ACTH))
#define p_qh ((f16_t*)WSP(WS_QH))
#define p_kh ((f16_t*)WSP(WS_KH))
#define p_vh ((f16_t*)WSP(WS_VH))
#define p_qih ((f16_t*)WSP(WS_QIH))
#define p_kih ((f16_t*)WSP(WS_KIH))
#define p_wi ((float*)WSP(WS_WI))
#define p_maskp ((unsigned long long*)WSP(WS_MASK))
#define p_opart ((f16_t*)WSP(WS_OPART))
#define p_ostat ((float*)WSP(WS_OSTAT))
#define lane ((int)(threadIdx.x & 63))
#define wave (__builtin_amdgcn_readfirstlane((int)(threadIdx.x >> 6)))
#define gw (bx * 8 + wave)
#define NGW (G * 8)

    PHASE(0) { for (int vb = bx; vb < 24 * ADA_KC; vb += G) nb_ada_part(p_c, p_w_ada, p_adap, vb, lds);
        LAS float* scr = (LAS float*)((LAS unsigned char*)lds + wave * 16896);
        for (int it = gw; it < (DM / 64) * (DINP / 64); it += NGW) transpose_item(p_w_in, DM, DIN, p_wtin, scr, DINP / 64, it, lane);
        for (int it = gw; it < (DM / 64) * (DM / 64); it += NGW) transpose_item(p_w_out, DM, DM, p_wtout, scr, DM / 64, it, lane);
        __syncthreads(); }
    SEAM(0);
    PHASE(1) { LAS float* tab = (LAS float*)((LAS unsigned char*)lds);
        for (int i = threadIdx.x; i < NB * DM; i += NT) { const int b = i / DM, col = i % DM; float sc = p_b_ada[A_SC1 + col], sh = p_b_ada[A_SH1 + col];
#pragma unroll
            for (int kc = 0; kc < ADA_KC; ++kc) { sc += p_adap[(size_t)(kc * 2 + b) * (6 * DM) + A_SC1 + col]; sh += p_adap[(size_t)(kc * 2 + b) * (6 * DM) + A_SH1 + col]; }
            tab[b * 2 * DM + col] = p_g_pre_mix[col] * (1.0f + sc); tab[b * 2 * DM + DM + col] = sh; }
        for (int i = bx * NT + threadIdx.x; i < NB * 6 * DM; i += G * NT) { float a = p_b_ada[i % (6 * DM)];
#pragma unroll
            for (int kc = 0; kc < ADA_KC; ++kc) a += p_adap[(size_t)kc * 2 * (6 * DM) + i];
            p_ada[i] = a; }
        __syncthreads();
        for (int t = gw; t < NTOK; t += NGW) ph_h1_row(p_x, tab, p_h1h, t, lane);
        __syncthreads(); }
    SEAM(1);
    PHASE(2) { pg8::Gemm g{p_h1h, p_wtin, NTOK, DINP, DM}; pg8::StaticOrder S; S.init(NTOK, DINP, G, bx);
        pg8::EpiF16G E{p_proj, DIN, DIN};
        pg8::gemm_phase<pg8::EpiF16G, pg8::StaticOrder>((LAS unsigned char*)lds, g, S, E); }
    SEAM(2);
    PHASE(3) { for (int t = gw; t < NTOK; t += NGW) ph_rope_conv_row(p_proj, p_positions, p_conv_w, p_g_conv_out, p_mergedh, p_qh, p_kh, p_vh, p_qih, p_kih, p_wi, t, lane); }
    SEAM(3);
    PHASE(4) { for (int it = bx; it < 256; it += G) { const int b = it >> 7, p = it & 127;
            ph_scores_block(p_qih, p_kih, p_wi, p_scores, b * SEQ + 16 * p, (LAS unsigned char*)lds);
            ph_scores_block(p_qih, p_kih, p_wi, p_scores, b * SEQ + 16 * (255 - p), (LAS unsigned char*)lds);
            asm volatile("s_waitcnt vmcnt(0)" ::: "memory"); __syncthreads();
            ph_select_row(p_scores, p_maskp, b * SEQ + 16 * p + 2 * wave, lane); ph_select_row(p_scores, p_maskp, b * SEQ + 16 * p + 2 * wave + 1, lane);
            ph_select_row(p_scores, p_maskp, b * SEQ + 16 * (255 - p) + 2 * wave, lane); ph_select_row(p_scores, p_maskp, b * SEQ + 16 * (255 - p) + 2 * wave + 1, lane); } }
    SEAM(4);
    PHASE(5) { for (int item = bx; item < 256; item += G) { att::attn_block(att_ref(2 * item, p_qh, p_kh, p_vh, p_maskp, p_opart, p_ostat), (char*)lds);
                                                              att::attn_block(att_ref(2 * item + 1, p_qh, p_kh, p_vh, p_maskp, p_opart, p_ostat), (char*)lds); } }
    SEAM(5);
    PHASE(6) { for (int t = gw; t < NTOK; t += 4 * NGW) ph_merge_rows4(p_opart, p_ostat, p_g_attn_out, p_mergedh, t, NGW, lane); }
    SEAM(6);
    PHASE(7) { pg8::Gemm g{p_mergedh, p_wtout, NTOK, DM, DM}; pg8::StaticOrder S; S.init(NTOK, DM, G, bx);
        pg8::EpiF32G E{p_mix, DM, DM};
        pg8::gemm_phase<pg8::EpiF32G, pg8::StaticOrder>((LAS unsigned char*)lds, g, S, E); }
    SEAM(7);
    PHASE(8) { LAS float* tab = (LAS float*)((LAS unsigned char*)lds); LAS float* part = tab + 4 * DM; LAS float* lg = part + 8 * 32 * 32;
        LAS int* cnt = (LAS int*)(lg + 32 * NE); LAS int* basee = cnt + NE; LAS int* rnk = basee + NE; LAS int* eid = rnk + 32 * TK;
        for (int un = bx; un < NTOK / 32; un += G) { const int tok0 = un * 32, b = tok0 / SEQ;
            for (int col = threadIdx.x; col < DM; col += NT) { tab[col] = p_ada[b * 6 * DM + A_GT1 + col]; tab[DM + col] = p_g_post_mix[col];
                tab[2 * DM + col] = p_g_pre_ffn[col] * (1.0f + p_ada[b * 6 * DM + A_SC2 + col]); tab[3 * DM + col] = p_ada[b * 6 * DM + A_SH2 + col]; }
            if (threadIdx.x < NE) cnt[threadIdx.x] = 0;
            __syncthreads();
            for (int i = 0; i < 4; ++i) ph_post_row(p_x, p_mix, tab, p_x1, p_h2, (unsigned char*)p_h2h, tok0 + 4 * wave + i, lane);
            asm volatile("s_waitcnt vmcnt(0)" ::: "memory"); __syncthreads();
            ph_router_mfma(p_h2, p_w_router, part, tok0, wave, lane);
            __syncthreads();
            { const int tk = threadIdx.x >> 4, e0 = (threadIdx.x & 15) * 2; float a0 = p_b_router[e0], a1 = p_b_router[e0 + 1];
#pragma unroll
              for (int w8 = 0; w8 < 8; ++w8) { a0 += part[(w8 * 32 + tk) * 32 + e0]; a1 += part[(w8 * 32 + tk) * 32 + e0 + 1]; }
              lg[tk * NE + e0] = a0; lg[tk * NE + e0 + 1] = a1; }
            __syncthreads();
            if (threadIdx.x < 32) { const int tk = threadIdx.x; float v[NE];
#pragma unroll
                for (int i = 0; i < NE; ++i) v[i] = lg[tk * NE + i];
                int idx[TK]; float val[TK];
#pragma unroll
                for (int k = 0; k < TK; ++k) { float best = -INFINITY; int bi = 0;
#pragma unroll
                    for (int i = 0; i < NE; ++i) { const bool take = v[i] > best; best = take ? v[i] : best; bi = take ? i : bi; }
                    idx[k] = bi; val[k] = best;
#pragma unroll
                    for (int i = 0; i < NE; ++i) v[i] = (i == bi) ? -INFINITY : v[i]; }
                float sm = 0.f, ex[TK];
#pragma unroll
                for (int k = 0; k < TK; ++k) { ex[k] = __expf(val[k] - val[0]); sm += ex[k]; }
#pragma unroll
                for (int k = 0; k < TK; ++k) { const int f = (tok0 + tk) * TK + k; p_topi[f] = idx[k]; p_gate[f] = ex[k] / sm;
                    eid[tk * TK + k] = idx[k]; rnk[tk * TK + k] = atomicAdd((int*)&cnt[idx[k]], 1); } }
            __syncthreads();
            if (threadIdx.x < NE) basee[threadIdx.x] = atomicAdd(&p_counts[threadIdx.x], cnt[threadIdx.x]);
            __syncthreads();
            if (threadIdx.x < 32 * TK) { const int f = tok0 * TK + threadIdx.x, e = eid[threadIdx.x], pos = basee[e] + rnk[threadIdx.x];
                p_lists[(size_t)e * NTOK + pos] = f; p_slotpos[f] = pos; }
            __syncthreads(); } }
    SEAM(8);
#define T_TE ((LAS int*)((LAS unsigned char*)lds + MISC_OFF + 1024))
#define T_TJ ((LAS int*)((LAS unsigned char*)lds + MISC_OFF + 1024 + 640))
#define T_PST ((LAS int*)((LAS unsigned char*)lds + MISC_OFF + 1024 + 1280))
#define T_CN ((LAS int*)((LAS unsigned char*)lds + MISC_OFF + 1024 + 1280 + 160))
#define T_NT ((LAS int*)((LAS unsigned char*)lds + MISC_OFF + 1024 + 1280 + 160 + 128))
    PHASE(9) {
        if (threadIdx.x == 0) { int tl = 0; for (int e = 0; e < NE; ++e) { const int cc = p_counts[e], nt_e = (cc + 255) >> 8; T_CN[e] = cc; T_PST[e] = tl * 256;
                for (int j = 0; j < nt_e; ++j) { T_TE[tl] = e; T_TJ[tl] = j; ++tl; } } T_PST[NE] = tl * 256; T_NT[0] = tl; }
        __syncthreads();
        unsigned* ctlw = (unsigned*)WSP(WS_CTL);
        constexpr int NCV = 3;
        const bool conv_all = (G != 256);
        if (conv_all || ((bx >> 3) & 7) < NCV) {
            LAS float* scq = (LAS float*)((LAS unsigned char*)lds + wave * 16896);
            const int crank = (bx >> 6) * (8 * NCV) + ((bx >> 3) & 7) * 8 + (bx & 7);
            for (unsigned it = conv_all ? (unsigned)bx : (unsigned)__builtin_amdgcn_readfirstlane(crank); it < 768u; it += conv_all ? (unsigned)G : 32u * NCV) {
                if (it < 512u) { const int e = (int)(it >> 4), part = (int)(it & 15);
                    tq_run16(p_w_gate_up + (size_t)e * DM * 2 * DFF, (unsigned char*)p_wtgu + (size_t)e * 2 * DFF * DM, DM, 2 * DFF, 32 * (part * 8 + wave), scq, lane, 32.0f);
                    asm volatile("s_waitcnt vmcnt(0)" ::: "memory"); __syncthreads();
                    if (threadIdx.x == 0) __hip_atomic_fetch_add(ctlw + CW_RDY0 + 64 * e, 1u, __ATOMIC_RELAXED, __HIP_MEMORY_SCOPE_AGENT); }
                else { const int e = (int)((it - 512u) >> 3), part = (int)((it - 512u) & 7);
                    tq_run16(p_w_down + (size_t)e * DFF * DM, (unsigned char*)p_wtdn + (size_t)e * DM * DFF, DFF, DM, 32 * (part * 8 + wave), scq, lane, 32.0f); }
            }
            asm volatile("s_waitcnt vmcnt(0)" ::: "memory"); __syncthreads();
        }
        pg8::Gemm g{p_h2h, p_wtgu, PMAX, 2 * DFF, DM / 2};
        pg8::DynOrderG S{2 * DFF / 256, T_NT[0], T_TE, T_TJ, T_CN, p_lists, (size_t)2 * DFF * DM, ctlw + CW_XQ, ctlw + CW_RDY0, 16u, ctlw + CW_TMO2, MISC + 26, -1, xb_xcc_id() & 7u};
        pg8::EpiSwigluQ E{(unsigned char*)p_acth, DFF, p_b_gate_up, 2 * DFF};
        pg8::gemm_phase<pg8::EpiSwigluQ, pg8::DynOrderG, false, true>((LAS unsigned char*)lds, g, S, E); }
    SEAM(9);
    PHASE(10) { pg8::Gemm g{p_acth, p_wtdn, PMAX, DM, DFF / 2}; unsigned* ctlw = (unsigned*)WSP(WS_CTL);
        pg8::DynOrderD S{DM / 256, T_NT[0], T_TE, T_TJ, T_CN, p_lists, (size_t)DM * DFF, ctlw + CW_XQ + 256, ctlw + CW_RDY0, 0u, ctlw + CW_TMO2, MISC + 26, -1, xb_xcc_id() & 7u};
        pg8::EpiF16Bias E{p_yrows, DM, p_b_down, DM};
        pg8::gemm_phase<pg8::EpiF16Bias, pg8::DynOrderD, false, true>((LAS unsigned char*)lds, g, S, E); }
    SEAM(10);
    PHASE(11) { LAS float* tab = (LAS float*)((LAS unsigned char*)lds + 1024);
        for (int i = threadIdx.x; i < NB * DM; i += NT) { const int b = i / DM, col = i % DM; tab[b * 2 * DM + col] = p_ada[b * 6 * DM + A_GT2 + col]; tab[b * 2 * DM + DM + col] = p_g_post_ffn[col]; }
        __syncthreads();
        for (int t = gw; t < NTOK; t += NGW) ph_final_row(p_x1, p_yrows, p_topi, p_gate, p_slotpos, T_PST, tab, p_out, t, lane); }
#undef T_TE
#undef T_TJ
#undef T_PST
#undef T_CN
#undef T_NT
#undef IN
#undef PHASE
#undef SEAM
#undef LO
#undef HI
#undef G
#undef NGW
}
#undef lane
#undef wave
#undef gw

extern "C" void kernel_launch(void* const* d_in, const int* in_sizes, int n_in, void* d_out, int out_size, void* d_ws, size_t ws_size, hipStream_t stream) {
    static int grid = 0;
    if (grid == 0) {
        if (n_in != 20 || ws_size < WS_END) { fprintf(stderr, "kernel_launch: unexpected n_in %d or ws_size %zu\n", n_in, ws_size); grid = -1; return; }
        int dev = 0, cus = 0, per_cu = 0;
        if (hipGetDevice(&dev) != hipSuccess || hipDeviceGetAttribute(&cus, hipDeviceAttributeMultiprocessorCount, dev) != hipSuccess) { grid = -1; return; }
        if (hipFuncSetAttribute((const void*)fwd, hipFuncAttributeMaxDynamicSharedMemorySize, LDS_BYTES) != hipSuccess) { fprintf(stderr, "kernel_launch: hipFuncSetAttribute failed\n"); grid = -1; return; }
        if (hipOccupancyMaxActiveBlocksPerMultiprocessor(&per_cu, (const void*)fwd, NT, LDS_BYTES) != hipSuccess || per_cu < 1) fprintf(stderr, "kernel_launch: occupancy query says %d\n", per_cu);
        (void)hipGetLastError();
        grid = cus;
    }
    if (grid < 0) return;
    if (hipMemsetAsync((char*)d_ws + WS_CTL, 0, CTL_ZERO_BYTES, stream) != hipSuccess) return;
    Args a{};
    for (int i = 0; i < 20; ++i) a.in[i] = d_in[i];
    a.out = (float*)d_out; a.ws = (unsigned char*)d_ws; a.ph_lo = 0; a.ph_hi = N_PHASES;
    hipLaunchKernelGGL(fwd, dim3(grid), dim3(NT), LDS_BYTES, stream, a);
}
```

```cpp
#include <hip/hip_runtime.h>
#include <cstdint>
#include <cstddef>
#include <cstdio>

#define NTOK 8192
#define SEQ 4096
#define NB 2
#define DM 2048
#define DCONV 1024
#define NH 8
#define NKV 2
#define HD 128
#define IH 16
#define IDIM 64
#define TOPK 256
#define DIN 5712
#define NE 32
#define TK 4
#define DFF 2048
#define NROWS (NTOK * TK)
#define O_BG 0
#define O_CG 1024
#define O_U 2048
#define O_Q 3072
#define O_K 4096
#define O_V 4352
#define O_QI 4608
#define O_KI 5632
#define O_WI 5696
#define A_SH1 0
#define A_SC1 2048
#define A_GT1 4096
#define A_SH2 6144
#define A_SC2 8192
#define A_GT2 10240
#define NT 512
#define ADA_KC 8
#define NTIQ 2048

#define LAS __attribute__((address_space(3)))

__device__ __constant__ float c_invf16[16] = {1.000000000e+00f, 4.403665960e-01f, 1.939227432e-01f, 8.539710194e-02f, 3.760603070e-02f, 1.656044088e-02f, 7.292664610e-03f, 3.211446106e-03f,
                                               1.414213562e-03f, 6.227724371e-04f, 2.742481884e-04f, 1.207697351e-04f, 5.318295734e-05f, 2.341999971e-05f, 1.031338525e-05f, 4.541670478e-06f};

#define XB_TMO      128
#define XB_XCNT(j)  (256  + 64 * (j))
#define XB_XSUB(j)  (1280 + 64 * (j))
#define XB_XGEN(j)  (2304 + 64 * (j))
#define XB_TOP      3328
#define XB_TOPGEN   3392
#define XCD_BAR_WORDS 3456
#define XB_SPIN_CAP (1u << 18)

__device__ __forceinline__ unsigned xb_ld(unsigned* p)              { return __hip_atomic_load(p, __ATOMIC_RELAXED, __HIP_MEMORY_SCOPE_AGENT); }
__device__ __forceinline__ unsigned xb_add(unsigned* p, unsigned v) { return __hip_atomic_fetch_add(p, v, __ATOMIC_RELAXED, __HIP_MEMORY_SCOPE_AGENT); }
__device__ __forceinline__ unsigned xb_xcc_id() { return (unsigned)__builtin_amdgcn_s_getreg((3 << 11) | 20) & 0xFu; }
#define XB_SPIN(cond, bar) do { unsigned _sp = 0; while (cond) { __builtin_amdgcn_s_sleep(1); \
    if ((++_sp & 255u) == 0u) { if (xb_ld(&(bar)[XB_TMO])) break; if (_sp > XB_SPIN_CAP) { atomicAdd(&(bar)[XB_TMO], 1u); break; } } } } while (0)

struct XcdBarrier { unsigned* bar; unsigned x; volatile LAS unsigned* st; };

__device__ __forceinline__ XcdBarrier xcd_barrier_post(unsigned* bar, volatile LAS unsigned* st) {
    XcdBarrier b; b.bar = bar; b.x = xb_xcc_id(); b.st = st;
    if (threadIdx.x == 0) (void)xb_add(&bar[XB_XCNT(b.x)], 1u);
    return b;
}
__device__ __forceinline__ void xcd_barrier_complete(unsigned* bar, unsigned x, unsigned& nloc, unsigned& nx) {
    const unsigned G = gridDim.x * gridDim.y * gridDim.z;
    unsigned sum, cnt, mine, sp = 0u;
    for (;;) {
        sum = 0u; cnt = 0u; mine = 0u;
#pragma unroll
        for (unsigned j = 0; j < 16; ++j) { const unsigned c = xb_ld(&bar[XB_XCNT(j)]); sum += c; cnt += (c > 0u) ? 1u : 0u; mine = (j == x) ? c : mine; }
        if (sum == G) break;
        __builtin_amdgcn_s_sleep(1);
        if ((++sp & 255u) == 0u) { if (xb_ld(&bar[XB_TMO])) break; if (sp > XB_SPIN_CAP) { atomicAdd(&bar[XB_TMO], 1u); break; } }
    }
    nloc = mine > 0u ? mine : 1u; nx = cnt > 0u ? cnt : 1u;
}
__device__ __forceinline__ void xcd_barrier(const XcdBarrier& b) {
    asm volatile("s_waitcnt vmcnt(0)" ::: "memory");
    __syncthreads();
    if (threadIdx.x == 0) {
        unsigned* bar = b.bar;
        __builtin_amdgcn_s_waitcnt(0);
        unsigned nloc = b.st[0], nx = b.st[1];
        if (nloc == 0u) { xcd_barrier_complete(bar, b.x, nloc, nx); b.st[0] = nloc; b.st[1] = nx; }
        const unsigned old = xb_add(&bar[XB_XSUB(b.x)], 1u);
        const unsigned gen = old / nloc;
        if (old + 1u == (gen + 1u) * nloc) {
            __builtin_amdgcn_fence(__ATOMIC_RELEASE, "agent");
            asm volatile("s_waitcnt vmcnt(0)" ::: "memory");
            const unsigned og = xb_add(&bar[XB_TOP], 1u);
            const unsigned tg = og / nx;
            if (og + 1u == (tg + 1u) * nx) xb_add(&bar[XB_TOPGEN], 1u);
            else XB_SPIN(xb_ld(&bar[XB_TOPGEN]) == tg, bar);
            __builtin_amdgcn_fence(__ATOMIC_ACQUIRE, "agent");
            xb_add(&bar[XB_XGEN(b.x)], 1u);
            asm volatile("s_waitcnt vmcnt(0)" ::: "memory");
        } else {
            XB_SPIN(xb_ld(&bar[XB_XGEN(b.x)]) == gen, bar);
            __builtin_amdgcn_fence(__ATOMIC_ACQUIRE, "agent");
            asm volatile("s_waitcnt vmcnt(0)" ::: "memory");
        }
    }
    __syncthreads();
}


typedef unsigned short f16_t;
typedef _Float16 f16x8 __attribute__((ext_vector_type(8)));
typedef _Float16 f16x2 __attribute__((ext_vector_type(2)));
typedef float f32x4 __attribute__((ext_vector_type(4)));
typedef unsigned u32x4 __attribute__((ext_vector_type(4)));
typedef unsigned u32x2 __attribute__((ext_vector_type(2)));
typedef int v4i_t __attribute__((ext_vector_type(4)));
typedef short s16x4_t __attribute__((ext_vector_type(4)));
typedef short s16x8_t __attribute__((ext_vector_type(8)));
typedef int v8i_t __attribute__((ext_vector_type(8)));
__device__ __forceinline__ unsigned pk4q(float a, float b, float c, float d) { int w = __builtin_amdgcn_cvt_pk_fp8_f32(a, b, 0, false); w = __builtin_amdgcn_cvt_pk_fp8_f32(c, d, w, true); return (unsigned)w; }
__device__ __forceinline__ unsigned pk2h(float lo, float hi) { f16x2 h; h.x = (_Float16)lo; h.y = (_Float16)hi; return __builtin_bit_cast(unsigned, h); }

namespace pg8 {
constexpr int BM = 256, BK = 64, HALF = 128, HTB = HALF * BK * 2, STAGE_BYTES = 8 * HTB, NXCD = 8, WGM = 8;
__host__ __device__ __forceinline__ int lds_byte(int r, int c) { const int st = (r >> 4) * 2 + (c >> 5), rr = r & 15, cc = c & 31, ob = rr * 64 + cc * 2; return st * 1024 + (ob ^ (((ob >> 9) & 1) << 5)); }
__host__ __device__ __forceinline__ void stage_rc(int b, int& R, int& C) { const int st = b / 1024, sb = b % 1024, swz = sb ^ (((sb >> 9) & 1) << 5); R = (st >> 1) * 16 + swz / 64; C = (st & 1) * 32 + (swz % 64) / 2; }
__host__ __device__ __forceinline__ int perm32(int rho) { const int n = rho >> 4, i = rho & 15; return 8 * (i >> 2) + 4 * n + (i & 3); }

struct Unit { int pm, pn, e; size_t boff; };
struct Gemm { const f16_t* A; const f16_t* Bt; int M, N, K; };

struct StaticOrder {
    int nM, nN, nwg, G, c;
    __host__ __device__ void init(int M, int N, int G_, int c_) { nM = M / BM; nN = N / BM; nwg = nM * nN; G = G_; c = c_; }
    __host__ __device__ bool next(int i, Unit& u) const {
        const long L = (long)i * G + c; if (L >= nwg) return false;
        int wgid = (int)L; { const int q = nwg / NXCD, r = nwg % NXCD, xcd = wgid % NXCD, off = wgid / NXCD; wgid = (xcd < r ? xcd * (q + 1) : r * (q + 1) + (xcd - r) * q) + off; }
        const int nig = WGM * nN, gid = wgid / nig, fm = gid * WGM, gsz = (nM - fm) < WGM ? (nM - fm) : WGM;
        u.pm = fm + ((wgid % nig) % gsz); u.pn = (wgid % nig) / gsz; u.boff = 0; u.e = 0; return true;
    }
    __device__ __forceinline__ void pre() const {}
    __device__ __forceinline__ unsigned a_off(const Unit& u, int h, int R, int K) const { return (unsigned)((u.pm * BM + h * HALF + R) * K) * 2u; }
    __device__ __forceinline__ void a_ready(const Unit&) const {}
    __device__ __forceinline__ void done(const Unit&) const {}
};

struct EpiF32G {
    static constexpr bool PERM = false, AFTER_DRAIN = false;
    float* C; int ldc; int ncols;
    __device__ __forceinline__ void operator()(const f32x4 (&acc)[2][2][4][2], const Unit& u, int wr, int wc, int fr, int fq) const {
        const int row0 = u.pm * BM + wr * 64 + fr, col0 = u.pn * BM + wc * 32 + 4 * fq;
#pragma unroll
        for (int ai = 0; ai < 2; ++ai)
#pragma unroll
            for (int m = 0; m < 4; ++m) { float* rowp = C + (size_t)(row0 + ai * HALF + m * 16) * ldc + col0;
#pragma unroll
                for (int bj = 0; bj < 2; ++bj)
#pragma unroll
                    for (int n = 0; n < 2; ++n) if (col0 + bj * HALF + n * 16 < ncols) *(f32x4*)(rowp + bj * HALF + n * 16) = acc[ai][bj][m][n]; }
    }
};

struct EpiF16G {
    static constexpr bool PERM = true, AFTER_DRAIN = false;
    f16_t* C; int ldc; int ncols;
    __device__ __forceinline__ void operator()(const f32x4 (&acc)[2][2][4][2], const Unit& u, int wr, int wc, int fr, int fq) const {
        const int row0 = u.pm * BM + wr * 64 + fr, col0 = u.pn * BM + wc * 32 + 8 * fq;
#pragma unroll
        for (int ai = 0; ai < 2; ++ai)
#pragma unroll
            for (int m = 0; m < 4; ++m) { f16_t* rowp = C + (size_t)(row0 + ai * HALF + m * 16) * ldc + col0;
#pragma unroll
                for (int bj = 0; bj < 2; ++bj) if (col0 + bj * HALF < ncols) { const f32x4 v0 = acc[ai][bj][m][0], v1 = acc[ai][bj][m][1];
                    u32x4 w; w.x = pk2h(v0[0], v0[1]); w.y = pk2h(v0[2], v0[3]); w.z = pk2h(v1[0], v1[1]); w.w = pk2h(v1[2], v1[3]);
                    *(u32x4*)(rowp + bj * HALF) = w; } }
    }
};
__device__ __forceinline__ unsigned pk2bf(float lo, float hi) {
    unsigned a = __float_as_uint(lo), b = __float_as_uint(hi);
    a += 0x7FFFu + ((a >> 16) & 1u); b += 0x7FFFu + ((b >> 16) & 1u);
    return (a >> 16) | (b & 0xFFFF0000u);
}
struct EpiBf16G {
    static constexpr bool PERM = true, AFTER_DRAIN = false;
    f16_t* C; int ldc; int ncols;
    __device__ __forceinline__ void operator()(const f32x4 (&acc)[2][2][4][2], const Unit& u, int wr, int wc, int fr, int fq) const {
        const int row0 = u.pm * BM + wr * 64 + fr, col0 = u.pn * BM + wc * 32 + 8 * fq;
#pragma unroll
        for (int ai = 0; ai < 2; ++ai)
#pragma unroll
            for (int m = 0; m < 4; ++m) { f16_t* rowp = C + (size_t)(row0 + ai * HALF + m * 16) * ldc + col0;
#pragma unroll
                for (int bj = 0; bj < 2; ++bj) if (col0 + bj * HALF < ncols) { const f32x4 v0 = acc[ai][bj][m][0], v1 = acc[ai][bj][m][1];
                    u32x4 w; w.x = pk2bf(v0[0], v0[1]); w.y = pk2bf(v0[2], v0[3]); w.z = pk2bf(v1[0], v1[1]); w.w = pk2bf(v1[2], v1[3]);
                    *(u32x4*)(rowp + bj * HALF) = w; } }
    }
};
struct EpiF16Bias {
    static constexpr bool PERM = true, AFTER_DRAIN = false;
    f16_t* C; int ldc; const float* bias; int nbias;
    __device__ __forceinline__ void operator()(const f32x4 (&acc)[2][2][4][2], const Unit& u, int wr, int wc, int fr, int fq) const {
        const int row0 = u.pm * BM + wr * 64 + fr, col0 = u.pn * BM + wc * 32 + 8 * fq;
        const float* bp = bias + (size_t)u.e * nbias + col0;
        f32x4 bv[2][2];
#pragma unroll
        for (int bj = 0; bj < 2; ++bj)
#pragma unroll
            for (int n = 0; n < 2; ++n) bv[bj][n] = *(const f32x4*)(bp + bj * HALF + 4 * n);
#pragma unroll
        for (int ai = 0; ai < 2; ++ai)
#pragma unroll
            for (int m = 0; m < 4; ++m) { f16_t* rowp = C + (size_t)(row0 + ai * HALF + m * 16) * ldc + col0;
#pragma unroll
                for (int bj = 0; bj < 2; ++bj) { const f32x4 v0 = acc[ai][bj][m][0] + bv[bj][0], v1 = acc[ai][bj][m][1] + bv[bj][1];
                    u32x4 w; w.x = pk2h(v0[0], v0[1]); w.y = pk2h(v0[2], v0[3]); w.z = pk2h(v1[0], v1[1]); w.w = pk2h(v1[2], v1[3]);
                    *(u32x4*)(rowp + bj * HALF) = w; } }
    }
};
struct EpiF16BiasN {
    static constexpr bool PERM = false, AFTER_DRAIN = false;
    f16_t* C; int ldc; const float* bias; int nbias;
    __device__ __forceinline__ void operator()(const f32x4 (&acc)[2][2][4][2], const Unit& u, int wr, int wc, int fr, int fq) const {
        const int row0 = u.pm * BM + wr * 64 + fr, col0 = u.pn * BM + wc * 32 + 4 * fq;
        const float* bp = bias + (size_t)u.e * nbias + col0;
        f32x4 bv[2][2];
#pragma unroll
        for (int bj = 0; bj < 2; ++bj)
#pragma unroll
            for (int n = 0; n < 2; ++n) bv[bj][n] = *(const f32x4*)(bp + bj * HALF + 16 * n);
#pragma unroll
        for (int ai = 0; ai < 2; ++ai)
#pragma unroll
            for (int m = 0; m < 4; ++m) { f16_t* rowp = C + (size_t)(row0 + ai * HALF + m * 16) * ldc + col0;
#pragma unroll
                for (int bj = 0; bj < 2; ++bj)
#pragma unroll
                    for (int n = 0; n < 2; ++n) { const f32x4 v = acc[ai][bj][m][n] + bv[bj][n]; u32x2 w; w.x = pk2h(v[0], v[1]); w.y = pk2h(v[2], v[3]); *(u32x2*)(rowp + bj * HALF + 16 * n) = w; } }
    }
};
template <bool GATHER> struct GroupedOrder {
    int nN, G, c, ntiles; const LAS int* te; const LAS int* tj; const LAS int* cn; const int* lists; size_t estride;
    __device__ __forceinline__ bool next(int i, Unit& u) const {
        if (G == 256 && nN == 8) {
            const int q = c & 7, w = c >> 3;
            u.pm = i * 32 + q * 4 + (w >> 3); u.pn = w & 7; if (u.pm >= ntiles) return false;
            u.e = te[u.pm]; u.boff = (size_t)u.e * estride; return true; }
        const long L = (long)i * G + c; if (L >= (long)ntiles * nN) return false;
        u.pm = (int)(L / nN); u.pn = (int)(L % nN); u.e = te[u.pm]; u.boff = (size_t)u.e * estride; return true;
    }
    __device__ __forceinline__ unsigned a_off(const Unit& u, int h, int R, int K) const {
        if (GATHER) { const int i = tj[u.pm] * BM + h * HALF + R; const int src = (i < cn[u.e]) ? (lists[(size_t)u.e * NTOK + i] >> 2) : 0; return (unsigned)(src * K) * 2u; }
        return (unsigned)((u.pm * BM + h * HALF + R) * K) * 2u;
    }
    __device__ __forceinline__ void pre() const {}
    __device__ __forceinline__ void a_ready(const Unit&) const {}
    __device__ __forceinline__ void done(const Unit&) const {}
};
template <int NN, bool GATHER> struct DynOrderT {
    int nN, ntiles; const LAS int* te; const LAS int* tj; const LAS int* cn; const int* lists; size_t estride;
    unsigned* qhead; unsigned* ready; unsigned need; unsigned* tmo; volatile LAS unsigned* slot; mutable int seen_e; unsigned xq; mutable unsigned pend; mutable bool armed;
    __device__ __forceinline__ void pre() const { if (armed) { armed = false; return; } if (threadIdx.x == 0) { unsigned z_; asm volatile("v_mov_b32 %0, 0" : "=v"(z_));
            pend = __hip_atomic_fetch_add(qhead + 32 * xq + z_, 1u, __ATOMIC_RELAXED, __HIP_MEMORY_SCOPE_AGENT); } }
    __device__ __forceinline__ bool next(int i, Unit& u) const {
        if (threadIdx.x == 0) { unsigned Lq = 0xFFFFFFFFu; unsigned idx = pend;
            for (int a_ = 0; a_ < 8; ++a_) { const unsigned q = (xq + (unsigned)a_) & 7u;
                if (a_ > 0) idx = __hip_atomic_fetch_add(qhead + 32 * q, 1u, __ATOMIC_RELAXED, __HIP_MEMORY_SCOPE_AGENT);
                const unsigned pm_ = ((idx / (2u * NN)) * 8u + q) * 2u + ((idx / NN) & 1u);
                if (pm_ < (unsigned)ntiles) { Lq = pm_ * NN + (idx % NN); break; } }
            slot[i & 1] = Lq; }
        asm volatile("s_waitcnt lgkmcnt(0)" ::: "memory"); __builtin_amdgcn_s_barrier(); asm volatile("" ::: "memory");
        const unsigned L = slot[i & 1];
        if (L >= (unsigned)(ntiles * nN)) return false;
        u.pm = (int)(L / (unsigned)nN); u.pn = (int)(L % (unsigned)nN); u.e = te[u.pm]; u.boff = (size_t)u.e * estride; return true;
    }
    __device__ __forceinline__ unsigned a_off(const Unit& u, int h, int R, int K) const {
        if (!GATHER) return (unsigned)((u.pm * BM + h * HALF + R) * K) * 2u;
        const int i = tj[u.pm] * BM + h * HALF + R; const int src = (i < cn[u.e]) ? (lists[(size_t)u.e * NTOK + i] >> 2) : 0; return (unsigned)(src * K) * 2u;
    }
    __device__ __forceinline__ void a_ready(const Unit& u) const {
        if (need == 0u) return;
        if (u.e == seen_e) return;
        seen_e = u.e;
        if (threadIdx.x < 64) { unsigned sp = 0;
            while ((unsigned)__builtin_amdgcn_readfirstlane((int)__hip_atomic_load(ready + 64 * u.e, __ATOMIC_RELAXED, __HIP_MEMORY_SCOPE_AGENT)) < need) {
                __builtin_amdgcn_s_sleep(4);
                if ((++sp & 255u) == 0u) { if (__builtin_amdgcn_readfirstlane((int)__hip_atomic_load(tmo, __ATOMIC_RELAXED, __HIP_MEMORY_SCOPE_AGENT)) != 0) break;
                    if (sp > (1u << 17)) { if (threadIdx.x == 0) __hip_atomic_store(tmo, 1u, __ATOMIC_RELAXED, __HIP_MEMORY_SCOPE_AGENT); break; } } }
            __builtin_amdgcn_fence(__ATOMIC_ACQUIRE, "agent");
            asm volatile("s_waitcnt vmcnt(0)" ::: "memory"); }
        asm volatile("" ::: "memory"); __builtin_amdgcn_s_barrier(); asm volatile("" ::: "memory");
    }
    __device__ __forceinline__ void done(const Unit&) const {}
};
template <bool PERM_> struct EpiSwigluT {
    static constexpr bool PERM = PERM_, AFTER_DRAIN = false;
    f16_t* O; int ldo; const float* bias; int nbias;
    static __device__ __forceinline__ float act1(float g_, float u_) { const float gt = fminf(g_, 7.0f), up = fminf(fmaxf(u_, -7.0f), 7.0f);
        return gt * __builtin_amdgcn_rcpf(1.0f + __builtin_amdgcn_exp2f(gt * (-1.702f * 1.4426950408889634f))) * (up + 1.0f); }
    __device__ __forceinline__ void operator()(const f32x4 (&acc)[2][2][4][2], const Unit& u, int wr, int wc, int fr, int fq) const {
        const int row0 = u.pm * BM + wr * 64 + fr, col0 = u.pn * BM + wc * 32 + (PERM_ ? 8 : 4) * fq;
        const float* bp = bias + (size_t)u.e * nbias + col0;
        f32x4 bv[2][2];
#pragma unroll
        for (int bj = 0; bj < 2; ++bj)
#pragma unroll
            for (int n = 0; n < 2; ++n) bv[bj][n] = *(const f32x4*)(bp + bj * HALF + (PERM_ ? 4 : 16) * n);
#pragma unroll
        for (int ai = 0; ai < 2; ++ai)
#pragma unroll
            for (int m = 0; m < 4; ++m) { f16_t* rowp = O + (size_t)(row0 + ai * HALF + m * 16) * ldo + (col0 >> 1);
#pragma unroll
                for (int bj = 0; bj < 2; ++bj) { const f32x4 v0 = acc[ai][bj][m][0] + bv[bj][0], v1 = acc[ai][bj][m][1] + bv[bj][1];
                    const unsigned w0 = pk2h(act1(v0[0], v0[1]), act1(v0[2], v0[3])), w1 = pk2h(act1(v1[0], v1[1]), act1(v1[2], v1[3]));
                    if (PERM_) { u32x2 w; w.x = w0; w.y = w1; *(u32x2*)(rowp + bj * (HALF / 2)) = w; }
                    else { *(unsigned*)(rowp + bj * (HALF / 2)) = w0; *(unsigned*)(rowp + bj * (HALF / 2) + 8) = w1; } } }
    }
};
typedef DynOrderT<16, true> DynOrderG;
typedef DynOrderT<8, false> DynOrderD;
typedef EpiSwigluT<true> EpiSwiglu;
struct EpiSwigluQ {
    static constexpr bool PERM = true, AFTER_DRAIN = false;
    unsigned char* O; int ldo; const float* bias; int nbias;
    __device__ __forceinline__ void operator()(const f32x4 (&acc)[2][2][4][2], const Unit& u, int wr, int wc, int fr, int fq) const {
        const int row0 = u.pm * BM + wr * 64 + fr, col0 = u.pn * BM + wc * 32 + 8 * fq;
        const float* bp = bias + (size_t)u.e * nbias + col0;
        f32x4 bv[2][2];
#pragma unroll
        for (int bj = 0; bj < 2; ++bj)
#pragma unroll
            for (int n = 0; n < 2; ++n) bv[bj][n] = *(const f32x4*)(bp + bj * HALF + 4 * n);
#pragma unroll
        for (int ai = 0; ai < 2; ++ai)
#pragma unroll
            for (int m = 0; m < 4; ++m) { unsigned char* rowp = O + (size_t)(row0 + ai * HALF + m * 16) * ldo + (col0 >> 1);
#pragma unroll
                for (int bj = 0; bj < 2; ++bj) { const f32x4 v0 = acc[ai][bj][m][0] + bv[bj][0], v1 = acc[ai][bj][m][1] + bv[bj][1];
                    *(unsigned*)(rowp + bj * (HALF / 2)) = pk4q(EpiSwigluT<true>::act1(v0[0], v0[1]), EpiSwigluT<true>::act1(v0[2], v0[3]), EpiSwigluT<true>::act1(v1[0], v1[1]), EpiSwigluT<true>::act1(v1[2], v1[3])); } }
    }
};
struct EpiF32Bias {
    static constexpr bool PERM = false, AFTER_DRAIN = false;
    float* C; int ldc; const float* bias; int nbias;
    __device__ __forceinline__ void operator()(const f32x4 (&acc)[2][2][4][2], const Unit& u, int wr, int wc, int fr, int fq) const {
        const int row0 = u.pm * BM + wr * 64 + fr, col0 = u.pn * BM + wc * 32 + 4 * fq;
        const float* bp = bias + (size_t)u.e * nbias + col0;
        f32x4 bv[2][2];
#pragma unroll
        for (int bj = 0; bj < 2; ++bj)
#pragma unroll
            for (int n = 0; n < 2; ++n) bv[bj][n] = *(const f32x4*)(bp + bj * HALF + n * 16);
#pragma unroll
        for (int ai = 0; ai < 2; ++ai)
#pragma unroll
            for (int m = 0; m < 4; ++m) { float* rowp = C + (size_t)(row0 + ai * HALF + m * 16) * ldc + col0;
#pragma unroll
                for (int bj = 0; bj < 2; ++bj)
#pragma unroll
                    for (int n = 0; n < 2; ++n) *(f32x4*)(rowp + bj * HALF + n * 16) = acc[ai][bj][m][n] + bv[bj][n]; }
    }
};

template <class Epi, class Sched, bool BKN = false, bool FP8 = false, bool ALIGN_EPI = true>
__device__ __forceinline__ void gemm_phase(LAS unsigned char* lds, const Gemm g, const Sched& S, const Epi& E) {
    const int tid = threadIdx.x, wid = __builtin_amdgcn_readfirstlane(tid >> 6), lane = tid & 63, wr = wid >> 2, wc = wid & 3, fr = lane & 15, fq = lane >> 4;
    const int K = g.K, nt = K / BK;
    unsigned voffB[2]; int RA[2]; unsigned CA2[2];
#pragma unroll
    for (int i = 0; i < 2; ++i) { int R, C; stage_rc(tid * 16 + i * 8192, R, C); const int Rb = Epi::PERM ? ((R & ~31) + perm32(R & 31)) : R;
        RA[i] = R; CA2[i] = (unsigned)C * 2u; voffB[i] = (unsigned)(Rb * K + C) * 2u;
        if constexpr (BKN) { static_assert(!Epi::PERM, "BKN needs PERM == false"); const int q = tid + 512 * i, kr = q >> 4, c16 = q & 15, sw = (kr & 3) | (((kr >> 3) & 1) << 2);
            voffB[i] = (unsigned)(kr * g.N + ((((c16 >> 1) ^ sw) << 4) + ((c16 & 1) << 3))) * 2u; } }
    const size_t kstep = (size_t)(BK * 2);
    const size_t hstep = (size_t)HALF * K * 2;
    const size_t kstepB = BKN ? (size_t)BK * g.N * 2 : kstep, hstepB = BKN ? (size_t)256 : hstep, tstep = BKN ? (size_t)512 : 2 * hstep;
    const unsigned ldsw = (unsigned)wid * 1024u;
    const int aoff = lds_byte(wr * 64 + fr, fq * 8), boff = lds_byte(wc * 32 + fr, fq * 8);
    int btr[2];
    { const int q4 = (lane >> 2) & 3, p4 = lane & 3, sw = q4 | ((fq & 1) << 2);
#pragma unroll
      for (int ns = 0; ns < 2; ++ns) btr[ns] = (int)(uintptr_t)lds + 65536 + (8 * fq + q4) * 256 + ((((wc * 2 + ns) ^ sw)) << 5) + 8 * p4; }
#define PG8_SA(b, h) (((b) * 2 + (h)) * HTB)
#define PG8_SB(b, h) ((4 + (b) * 2 + (h)) * HTB)
#define PG8_STAGE(bufoff, ubase, off32, voff) do { _Pragma("unroll") for (int _i = 0; _i < 2; ++_i) \
        __builtin_amdgcn_global_load_lds((const unsigned*)((const char*)(ubase) + (unsigned)((voff)[_i] + (unsigned)(off32))), (LAS unsigned*)(lds + (bufoff) + ldsw + _i * 8192), 16, 0, 0); } while (0)
#define PG8_STAGEA(bufoff, koff, v0_, v1_) do { \
        __builtin_amdgcn_global_load_lds((const unsigned*)((const char*)g.A + (unsigned)((v0_) + (unsigned)(koff))), (LAS unsigned*)(lds + (bufoff) + ldsw), 16, 0, 0); \
        __builtin_amdgcn_global_load_lds((const unsigned*)((const char*)g.A + (unsigned)((v1_) + (unsigned)(koff))), (LAS unsigned*)(lds + (bufoff) + ldsw + 8192), 16, 0, 0); } while (0)
#define PG8_SETA(v, u) do { _Pragma("unroll") for (int h_ = 0; h_ < 2; ++h_) _Pragma("unroll") for (int i_ = 0; i_ < 2; ++i_) v[h_][i_] = S.a_off(u, h_, RA[i_], K) + CA2[i_]; } while (0)
#define PG8_LDA(dst, b, h) do { _Pragma("unroll") for (int m = 0; m < 4; ++m) _Pragma("unroll") for (int k = 0; k < 2; ++k) dst[m][k] = *(const LAS f16x8*)(lds + PG8_SA(b, h) + aoff + m * 2048 + k * 1024); } while (0)
#define PG8_TRRD(dst, addr, off) asm volatile("ds_read_b64_tr_b16 %0, %1 offset:%2" : "=&v"(dst) : "v"(addr), "i"(off) : "memory")
#define PG8_LDB(dst, b, h) do { if constexpr (BKN) { _Pragma("unroll") for (int n = 0; n < 2; ++n) _Pragma("unroll") for (int k = 0; k < 2; ++k) { s16x4_t lo_, hi_; \
            PG8_TRRD(lo_, btr[n], ((b) * 2 + (h)) * HTB + k * 8192); PG8_TRRD(hi_, btr[n], ((b) * 2 + (h)) * HTB + k * 8192 + 1024); \
            dst[n][k] = __builtin_bit_cast(f16x8, (s16x8_t){lo_[0], lo_[1], lo_[2], lo_[3], hi_[0], hi_[1], hi_[2], hi_[3]}); } } \
        else { _Pragma("unroll") for (int n = 0; n < 2; ++n) _Pragma("unroll") for (int k = 0; k < 2; ++k) dst[n][k] = *(const LAS f16x8*)(lds + PG8_SB(b, h) + boff + n * 2048 + k * 1024); } } while (0)
#define PG8_V8(x0, x1) __builtin_shufflevector(__builtin_bit_cast(v4i_t, x0), __builtin_bit_cast(v4i_t, x1), 0, 1, 2, 3, 4, 5, 6, 7)
#define PG8_MMA(ai, bj, At, Bt) do { __builtin_amdgcn_s_setprio(1); if constexpr (FP8) { _Pragma("unroll") for (int m = 0; m < 4; ++m) _Pragma("unroll") for (int n = 0; n < 2; ++n) \
            asm volatile("v_mfma_scale_f32_16x16x128_f8f6f4 %0, %1, %2, %0, %3, %4 op_sel_hi:[0,0,0]" : "+v"(acc[ai][bj][m][n]) : "v"(PG8_V8(Bt[n][0], Bt[n][1])), "v"(PG8_V8(At[m][0], At[m][1])), "v"(sclW), "v"(sclX)); } \
        else { _Pragma("unroll") for (int m = 0; m < 4; ++m) _Pragma("unroll") for (int n = 0; n < 2; ++n) _Pragma("unroll") for (int k = 0; k < 2; ++k) \
            acc[ai][bj][m][n] = __builtin_amdgcn_mfma_f32_16x16x32_f16(Bt[n][k], At[m][k], acc[ai][bj][m][n], 0, 0, 0); } __builtin_amdgcn_s_setprio(0); } while (0)
#define PG8_WAIT_V(n) asm volatile("s_waitcnt vmcnt(" #n ")" ::: "memory")
#define PG8_WAIT_L(n) asm volatile("s_waitcnt lgkmcnt(" #n ")" ::: "memory")
#define PG8_BAR __builtin_amdgcn_s_barrier()
#define PG8_SCHED __builtin_amdgcn_sched_barrier(0)
    Unit cur, nxt; int ui = 0;
    S.pre();
    if (!S.next(0, cur)) return;
    S.pre();
    f32x4 acc[2][2][4][2];
#pragma unroll
    for (int a = 0; a < 2; ++a)
#pragma unroll
        for (int b = 0; b < 2; ++b)
#pragma unroll
            for (int m = 0; m < 4; ++m)
#pragma unroll
                for (int n = 0; n < 2; ++n) acc[a][b][m][n] = (f32x4){0.f, 0.f, 0.f, 0.f};
    f16x8 At[4][2], B0[2][2], B1[2][2];
    const int sclW = 0x7A7A7A7A, sclX = 0x7F7F7F7F;
    unsigned vAc[2][2], vAn[2][2];
    PG8_SETA(vAc, cur);
    const char* cB = (const char*)g.Bt + cur.boff + (size_t)cur.pn * tstep;
    S.a_ready(cur);
    PG8_STAGE(PG8_SB(0, 0), cB, 0, voffB); PG8_STAGE(PG8_SB(0, 1), cB, hstepB, voffB); PG8_STAGEA(PG8_SA(0, 0), 0, vAc[0][0], vAc[0][1]); PG8_STAGEA(PG8_SA(0, 1), 0, vAc[1][0], vAc[1][1]);
    if (wr == 1) PG8_BAR;
    PG8_WAIT_V(2); PG8_BAR;
    PG8_STAGE(PG8_SB(1, 0), cB, kstepB, voffB); PG8_STAGEA(PG8_SA(1, 0), kstep, vAc[0][0], vAc[0][1]); PG8_STAGE(PG8_SB(1, 1), cB, hstepB + kstepB, voffB);
    PG8_WAIT_V(6); PG8_BAR;
    for (;;) {
        const bool has_next = S.next(ui + 1, nxt);
        if (has_next) { PG8_SETA(vAn, nxt); }
        else {
#pragma unroll
            for (int h_ = 0; h_ < 2; ++h_)
#pragma unroll
                for (int i_ = 0; i_ < 2; ++i_) vAn[h_][i_] = vAc[h_][i_]; }
        const char* nB = has_next ? (const char*)g.Bt + nxt.boff + (size_t)nxt.pn * tstep : cB;
        for (int t = 0; t < nt; t += 2) {
            const bool last = (t == nt - 2);
            const size_t k1 = (size_t)(t + 1) * kstep, k2 = last ? (size_t)0 : (size_t)(t + 2) * kstep, k3 = k2 + kstep;
            const unsigned w00 = last ? vAn[0][0] : vAc[0][0], w01 = last ? vAn[0][1] : vAc[0][1], w10 = last ? vAn[1][0] : vAc[1][0], w11 = last ? vAn[1][1] : vAc[1][1];
            const char* bb = last ? nB : cB; const unsigned o2 = last ? 0u : (unsigned)((size_t)(t + 2) * kstepB), o3 = o2 + (unsigned)kstepB;
            if (last && has_next) S.a_ready(nxt);
            PG8_LDB(B0, 0, 0); PG8_LDB(B1, 0, 1); PG8_SCHED; PG8_LDA(At, 0, 0); PG8_STAGEA(PG8_SA(1, 1), k1, vAc[1][0], vAc[1][1]);
            PG8_WAIT_V(8); PG8_WAIT_L(0); PG8_SCHED; PG8_BAR; PG8_MMA(0, 0, At, B0); PG8_MMA(0, 1, At, B1); PG8_BAR; PG8_SCHED;
            PG8_LDA(At, 0, 1); PG8_STAGE(PG8_SB(0, 0), bb, o2, voffB); PG8_STAGE(PG8_SB(0, 1), bb, o2 + (unsigned)hstepB, voffB); PG8_STAGEA(PG8_SA(0, 0), k2, w00, w01);
            PG8_WAIT_V(8); PG8_WAIT_L(0); PG8_BAR; PG8_MMA(1, 0, At, B0); PG8_MMA(1, 1, At, B1); PG8_BAR; PG8_SCHED;
            PG8_LDB(B0, 1, 0); PG8_LDB(B1, 1, 1); PG8_SCHED; PG8_LDA(At, 1, 0); PG8_STAGEA(PG8_SA(0, 1), k2, w10, w11);
            PG8_WAIT_V(8); PG8_WAIT_L(0); PG8_SCHED; PG8_BAR; PG8_MMA(0, 0, At, B0); PG8_MMA(0, 1, At, B1); PG8_BAR; PG8_SCHED;
            PG8_LDA(At, 1, 1); PG8_STAGE(PG8_SB(1, 0), bb, o3, voffB); PG8_STAGE(PG8_SB(1, 1), bb, o3 + (unsigned)hstepB, voffB); PG8_STAGEA(PG8_SA(1, 0), k3, w00, w01);
            PG8_WAIT_V(8); PG8_WAIT_L(0); PG8_BAR; PG8_MMA(1, 0, At, B0); PG8_MMA(1, 1, At, B1); PG8_BAR; PG8_SCHED;
        }
        if constexpr (ALIGN_EPI) { if (wr == 0) PG8_BAR; }
        if constexpr (FP8) { asm volatile("s_nop 15\n\ts_nop 15" ::: "memory"); }
        if (has_next) S.pre();
        E(acc, cur, wr, wc, fr, fq); S.done(cur);
        if (!has_next) break;
#pragma unroll
        for (int a = 0; a < 2; ++a)
#pragma unroll
            for (int b = 0; b < 2; ++b)
#pragma unroll
                for (int m = 0; m < 4; ++m)
#pragma unroll
                    for (int n = 0; n < 2; ++n) acc[a][b][m][n] = (f32x4){0.f, 0.f, 0.f, 0.f};
        cur = nxt; cB = nB; ++ui;
#pragma unroll
        for (int h_ = 0; h_ < 2; ++h_)
#pragma unroll
            for (int i_ = 0; i_ < 2; ++i_) vAc[h_][i_] = vAn[h_][i_];
        if constexpr (ALIGN_EPI) { if (wr == 1) PG8_BAR; }
    }
    PG8_WAIT_V(0);
    if constexpr (!ALIGN_EPI) { if (wr == 0) PG8_BAR; }
    PG8_BAR;
#undef PG8_SA
#undef PG8_SB
#undef PG8_STAGE
#undef PG8_STAGEA
#undef PG8_SETA
#undef PG8_LDA
#undef PG8_LDB
#undef PG8_TRRD
#undef PG8_MMA
#undef PG8_V8
#undef PG8_WAIT_V
#undef PG8_WAIT_L
#undef PG8_BAR
#undef PG8_SCHED
}
}

__device__ __forceinline__ void transpose_item(const float* W, int K, int N, f16_t* WT, LAS float* scr, int nblk, int item, int lane) {
    const int kb = item / nblk, nb = item % nblk, k0 = 64 * kb, n0 = 64 * nb;
    const int kr = lane >> 4, nq = (lane & 15) * 4;
    const bool ok = (n0 + nq) < N;
    f32x4 v[16];
#pragma unroll
    for (int i = 0; i < 16; ++i) v[i] = ok ? *(const f32x4*)(W + (size_t)(k0 + 4 * i + kr) * N + n0 + nq) : (f32x4){0.f, 0.f, 0.f, 0.f};
#pragma unroll
    for (int i = 0; i < 16; ++i) { LAS float* d = scr + (4 * i + kr) * 65 + nq; d[0] = v[i][0]; d[1] = v[i][1]; d[2] = v[i][2]; d[3] = v[i][3]; }
    asm volatile("s_waitcnt lgkmcnt(0)" ::: "memory");
    const int c = lane & 7;
#pragma unroll
    for (int j = 0; j < 8; ++j) { const int n = (lane >> 3) + 8 * j; const LAS float* sp = scr + (8 * c) * 65 + n;
        u32x4 o; o.x = pk2h(sp[0 * 65], sp[1 * 65]); o.y = pk2h(sp[2 * 65], sp[3 * 65]); o.z = pk2h(sp[4 * 65], sp[5 * 65]); o.w = pk2h(sp[6 * 65], sp[7 * 65]);
        *(u32x4*)(WT + (size_t)(n0 + n) * K + k0 + 8 * c) = o; }
    asm volatile("s_waitcnt lgkmcnt(0)" ::: "memory");
}

__device__ __forceinline__ void transpose_item_q(const float* W, int K, int N, unsigned char* WQ, LAS float* scr, int nblk, int item, int lane, float scale) {
    const int kb = item / nblk, nb = item % nblk, k0 = 128 * kb, n0 = 32 * nb;
    const int kr = lane >> 3, nq = (lane & 7) * 4;
    f32x4 v[16];
#pragma unroll
    for (int i = 0; i < 16; ++i) v[i] = __builtin_nontemporal_load((const f32x4*)(W + (size_t)(k0 + 8 * i + kr) * N + n0 + nq));
#pragma unroll
    for (int i = 0; i < 16; ++i) { LAS float* d = scr + (8 * i + kr) * 33 + nq; d[0] = v[i][0] * scale; d[1] = v[i][1] * scale; d[2] = v[i][2] * scale; d[3] = v[i][3] * scale; }
    asm volatile("s_waitcnt lgkmcnt(0)" ::: "memory");
    const int c = lane & 7;
#pragma unroll
    for (int j = 0; j < 4; ++j) { const int n = (lane >> 3) + 8 * j; const LAS float* sp = scr + (16 * c) * 33 + n;
        u32x4 o; o.x = pk4q(sp[0 * 33], sp[1 * 33], sp[2 * 33], sp[3 * 33]); o.y = pk4q(sp[4 * 33], sp[5 * 33], sp[6 * 33], sp[7 * 33]);
        o.z = pk4q(sp[8 * 33], sp[9 * 33], sp[10 * 33], sp[11 * 33]); o.w = pk4q(sp[12 * 33], sp[13 * 33], sp[14 * 33], sp[15 * 33]);
        *(u32x4*)(WQ + (size_t)(n0 + n) * K + k0 + 16 * c) = o; }
    asm volatile("s_waitcnt lgkmcnt(0)" ::: "memory");
}

__device__ __forceinline__ void tq_issue(f32x4 (&v)[16], const float* W, int N, int k0, int n0, int lane) {
    const int kr = lane >> 3, nq = (lane & 7) * 4;
#pragma unroll
    for (int i = 0; i < 16; ++i) v[i] = __builtin_nontemporal_load((const f32x4*)(W + (size_t)(k0 + 8 * i + kr) * N + n0 + nq));
}
__device__ __forceinline__ void tq_finish(const f32x4 (&v)[16], unsigned char* WQ, int K, int k0, int n0, LAS float* scr, int lane, float scale) {
    const int kr = lane >> 3, nq = (lane & 7) * 4;
#pragma unroll
    for (int i = 0; i < 16; ++i) { LAS float* d = scr + (8 * i + kr) * 33 + (nq ^ (4 * ((i >> 2) & 3))); d[0] = v[i][0] * scale; d[1] = v[i][1] * scale; d[2] = v[i][2] * scale; d[3] = v[i][3] * scale; }
    asm volatile("s_waitcnt lgkmcnt(0)" ::: "memory");
    const int c = lane & 7;
#pragma unroll
    for (int j = 0; j < 4; ++j) { const int n = (lane >> 3) + 8 * j; const LAS float* sp = scr + (16 * c) * 33 + (n ^ (4 * ((c >> 1) & 3)));
        u32x4 o; o.x = pk4q(sp[0 * 33], sp[1 * 33], sp[2 * 33], sp[3 * 33]); o.y = pk4q(sp[4 * 33], sp[5 * 33], sp[6 * 33], sp[7 * 33]);
        o.z = pk4q(sp[8 * 33], sp[9 * 33], sp[10 * 33], sp[11 * 33]); o.w = pk4q(sp[12 * 33], sp[13 * 33], sp[14 * 33], sp[15 * 33]);
        asm volatile("global_store_dwordx4 %0, %1, off sc1 nt\n\ts_nop 1" :: "v"(WQ + (size_t)(n0 + n) * K + k0 + 16 * c), "v"(o) : "memory"); }
    asm volatile("s_waitcnt lgkmcnt(0)" ::: "memory");
}
__device__ __forceinline__ void tq_run16(const float* W, unsigned char* WQ, int K, int N, int n0, LAS float* scr, int lane, float scale) {
    f32x4 va[16], vb[16];
    tq_issue(va, W, N, 0, n0, lane);
#pragma unroll 1
    for (int j = 0; j < 16; j += 2) {
        tq_issue(vb, W, N, 128 * (j + 1), n0, lane);
        tq_finish(va, WQ, K, 128 * j, n0, scr, lane, scale);
        if (j + 2 < 16) tq_issue(va, W, N, 128 * (j + 2), n0, lane);
        tq_finish(vb, WQ, K, 128 * (j + 1), n0, scr, lane, scale);
    }
}

constexpr size_t MiB = 1u << 20;
constexpr size_t WS_CTL = 0, CTL_ZERO_BYTES = 1 * MiB;
constexpr int CW_BAR = 4096;
constexpr int CW_XQ = 12288  ;
constexpr int CW_Q4 = 13312, CW_Q5 = 13344;
constexpr int CW_TQ = 8192, CW_GQ = 8256, CW_RDY0 = 8320  , CW_TMO2 = 10432;
constexpr size_t WS_ADAP = 1 * MiB;
constexpr size_t WS_ADA = 2 * MiB;
constexpr size_t WS_TOPI = 3 * MiB;
constexpr size_t WS_GATE = 4 * MiB;
constexpr size_t WS_LISTS = 5 * MiB;
constexpr size_t WS_COUNTS = 6 * MiB;
constexpr size_t WS_SLOT = 7 * MiB;
constexpr size_t WS_SEL = 8 * MiB;
constexpr size_t WS_H1H = 16 * MiB;
constexpr size_t WS_PROJ = 80 * MiB;
constexpr size_t WS_SCORES = 260 * MiB;
constexpr size_t WS_MERGEDH = 388 * MiB;
constexpr size_t WS_MIX = 452 * MiB;
constexpr size_t WS_X1 = 516 * MiB;
constexpr size_t WS_H2 = 580 * MiB;
constexpr size_t WS_H2H = 644 * MiB;
constexpr size_t WS_WTIN = 676 * MiB;
constexpr size_t WS_WTOUT = 700 * MiB;
constexpr size_t WS_WTGU = 708 * MiB;
constexpr size_t WS_WTDN = 1220 * MiB;
constexpr size_t WS_XG = 1476 * MiB;
constexpr size_t WS_ACTH = 1636 * MiB;
constexpr size_t WS_YROWS = 1796 * MiB;
constexpr size_t WS_QH = 2116 * MiB;
constexpr size_t WS_KH = 2132 * MiB;
constexpr size_t WS_VH = 2136 * MiB;
constexpr size_t WS_QIH = 2140 * MiB;
constexpr size_t WS_KIH = 2156 * MiB;
constexpr size_t WS_WI = 2157 * MiB;
constexpr size_t WS_MASK = 2158 * MiB;
constexpr size_t WS_OPART = 2162 * MiB;
constexpr size_t WS_OSTAT = 2194 * MiB;
constexpr size_t WS_END = 2196 * MiB;
#define DINP 5888
#define PMAX 40960

constexpr int LDS_BYTES = 147456;
constexpr int MISC_OFF = 139264;

struct Args { const void* in[20]; float* out; unsigned char* ws; int ph_lo, ph_hi; };

__device__ __forceinline__ void rope_cs(int pos, float invf, float& c, float& s) {
    const float ang = (float)pos * invf;
    const double rev = (double)ang * 0.15915494309189535;
    const double fr = rev - floor(rev);
    const float f = (float)fr;
    s = __builtin_amdgcn_sinf(f);
    c = __builtin_amdgcn_cosf(f);
}
__device__ __forceinline__ float bsum(float v, float* red) {
    for (int o = 32; o >= 1; o >>= 1) v += __shfl_xor(v, o);
    __syncthreads();
    if ((threadIdx.x & 63) == 0) red[threadIdx.x >> 6] = v;
    __syncthreads();
    return ((red[0] + red[1]) + (red[2] + red[3])) + ((red[4] + red[5]) + (red[6] + red[7]));
}
__device__ __forceinline__ float bmax(float v, float* red) {
    for (int o = 32; o >= 1; o >>= 1) v = fmaxf(v, __shfl_xor(v, o));
    __syncthreads();
    if ((threadIdx.x & 63) == 0) red[threadIdx.x >> 6] = v;
    __syncthreads();
    return fmaxf(fmaxf(fmaxf(red[0], red[1]), fmaxf(red[2], red[3])), fmaxf(fmaxf(red[4], red[5]), fmaxf(red[6], red[7])));
}

__device__ __forceinline__ void nb_ada_part(const float* c, const float* w, float* part, int vb, unsigned char* lds) {
    float* sc = (float*)lds;
    float* red = sc + 512;
    const int jb = vb / ADA_KC, kc = vb % ADA_KC, k0 = kc * (DM / ADA_KC);
    { const int b = threadIdx.x >> 8, k = threadIdx.x & 255; const float v = c[b * DM + k0 + k]; sc[b * 256 + k] = v / (1.0f + expf(-v)); }
    __syncthreads();
    const int kg = threadIdx.x >> 7, jq = (threadIdx.x & 127) * 4;
    const float* wp = w + (size_t)(k0 + 64 * kg) * (6 * DM) + jb * NT + jq;
    f32x4 a0 = {0.f, 0.f, 0.f, 0.f}, a1 = {0.f, 0.f, 0.f, 0.f};
#pragma unroll 16
    for (int k = 0; k < 64; ++k) { const f32x4 wv = __builtin_nontemporal_load((const f32x4*)(wp + (size_t)k * (6 * DM))); const float s0 = sc[64 * kg + k], s1 = sc[256 + 64 * kg + k];
        a0 += s0 * wv; a1 += s1 * wv; }
    *(f32x4*)(red + (kg * 2 + 0) * 512 + jq) = a0; *(f32x4*)(red + (kg * 2 + 1) * 512 + jq) = a1;
    __syncthreads();
    const int j = jb * NT + threadIdx.x;
    float r0 = 0.f, r1 = 0.f;
#pragma unroll
    for (int g4 = 0; g4 < 4; ++g4) { r0 += red[(g4 * 2 + 0) * 512 + threadIdx.x]; r1 += red[(g4 * 2 + 1) * 512 + threadIdx.x]; }
    part[((size_t)kc * 2 + 0) * (6 * DM) + j] = r0; part[((size_t)kc * 2 + 1) * (6 * DM) + j] = r1;
    __syncthreads();
}

__device__ __forceinline__ void nb_modnorm(const float* x, const float* g, const float* ada, int sh_off, int sc_off, f16_t* out, int t, unsigned char* lds) {
    float* red = (float*)lds;
    const int bb = t / SEQ; const float* xr = x + (size_t)t * DM;
    float v[4]; float ss = 0.f;
#pragma unroll
    for (int i = 0; i < 4; ++i) { v[i] = xr[threadIdx.x + i * NT]; ss += v[i] * v[i]; }
    ss = bsum(ss, red);
    const float rstd = rsqrtf(ss * (1.0f / DM) + 1e-6f);
#pragma unroll
    for (int i = 0; i < 4; ++i) { const int col = threadIdx.x + i * NT;
        const float hv = v[i] * rstd * g[col] * (1.0f + ada[bb * 6 * DM + sc_off + col]) + ada[bb * 6 * DM + sh_off + col];
        out[(size_t)t * DM + col] = __builtin_bit_cast(unsigned short, (_Float16)hv); }
    __syncthreads();
}

template <int MODE>
__device__ __forceinline__ void nb_sgemm(const float* A, const float* B, const float* bias, float* C, int M, int N, int K, int lda, int ldb, int ldc,
                                         const int* lists, int rowbase, int m0, int n0, unsigned char* lds) {
    float (*As)[132] = (float (*)[132])lds;
    float (*Bs)[68] = (float (*)[68])(lds + 16 * 132 * 4);
    const int tid = threadIdx.x, tx = tid & 15, ty = tid >> 4;
    const int ar = tid >> 2, ak = (tid & 3) * 4;
    const int bk = (tid >> 4) & 15, bn = (tid & 15) * 4;
    const float* arow = nullptr;
    if (m0 + ar < M) {
        if (MODE == 0) arow = A + (size_t)(m0 + ar) * lda;
        else if (MODE == 1) arow = A + (size_t)(lists[m0 + ar] >> 2) * lda;
        else arow = A + (size_t)(rowbase + m0 + ar) * lda;
    }
    const bool bok = (tid < 256) && ((n0 + bn) < N);
    float acc[4][4];
#pragma unroll
    for (int i = 0; i < 4; ++i)
#pragma unroll
        for (int j = 0; j < 4; ++j) acc[i][j] = 0.f;
    for (int k0 = 0; k0 < K; k0 += 16) {
        float4 av = make_float4(0.f, 0.f, 0.f, 0.f), bv = make_float4(0.f, 0.f, 0.f, 0.f);
        if (arow) av = *(const float4*)(arow + k0 + ak);
        if (bok) bv = *(const float4*)(B + (size_t)(k0 + bk) * ldb + n0 + bn);
        __syncthreads();
        As[ak + 0][ar] = av.x; As[ak + 1][ar] = av.y; As[ak + 2][ar] = av.z; As[ak + 3][ar] = av.w;
        if (tid < 256) *(float4*)&Bs[bk][bn] = bv;
        __syncthreads();
#pragma unroll
        for (int kk = 0; kk < 16; ++kk) {
            const float4 a4 = *(const float4*)&As[kk][ty * 4];
            const float4 b4 = *(const float4*)&Bs[kk][tx * 4];
            const float a[4] = {a4.x, a4.y, a4.z, a4.w}, b[4] = {b4.x, b4.y, b4.z, b4.w};
#pragma unroll
            for (int i = 0; i < 4; ++i)
#pragma unroll
                for (int j = 0; j < 4; ++j) acc[i][j] += a[i] * b[j];
        }
    }
#pragma unroll
    for (int i = 0; i < 4; ++i) { const int m = m0 + ty * 4 + i;
        if (m < M) { const size_t crow = (MODE == 0) ? (size_t)m : (size_t)(rowbase + m);
#pragma unroll
            for (int j = 0; j < 4; ++j) { const int n = n0 + tx * 4 + j; if (n < N) C[crow * ldc + n] = acc[i][j] + (bias ? bias[n] : 0.f); } } }
    __syncthreads();
}

__device__ __forceinline__ void nb_rope_conv(float* proj, const int* positions, const float* cw, const float* g, f16_t* merged, f16_t* qh, f16_t* kh, f16_t* vh, f16_t* qih, f16_t* kih, float* wi, int t, unsigned char* lds) {
    float* red = (float*)lds;
    const int pos = positions[t]; float* pr = proj + (size_t)t * DIN;
    for (int i = threadIdx.x; i < (NH + NKV) * 16; i += NT) { const int h = i >> 4, j = i & 15;
        float* p = (h < NH) ? (pr + O_Q + h * HD) : (pr + O_K + (h - NH) * HD);
        float c, s; rope_cs(pos, c_invf16[j], c, s);
        const float x1 = p[j], x2 = p[j + 16]; p[j] = x1 * c - x2 * s; p[j + 16] = x2 * c + x1 * s; }
    for (int i = threadIdx.x; i < (IH + 1) * 8; i += NT) { const int h = i >> 3, j = i & 7;
        float* p = (h < IH) ? (pr + O_QI + h * IDIM) : (pr + O_KI);
        float c, s; rope_cs(pos, c_invf16[2 * j], c, s);
        const float x1 = p[j], x2 = p[j + 8]; p[j] = x1 * c - x2 * s; p[j + 8] = x2 * c + x1 * s; }
    __syncthreads();
    for (int i = threadIdx.x; i < 1024; i += NT) { qh[(size_t)t * 1024 + i] = __builtin_bit_cast(unsigned short, (_Float16)pr[O_Q + i]); qih[(size_t)t * 1024 + i] = __builtin_bit_cast(unsigned short, (_Float16)pr[O_QI + i]); }
    if (threadIdx.x < 256) { kh[(size_t)t * 256 + threadIdx.x] = __builtin_bit_cast(unsigned short, (_Float16)pr[O_K + threadIdx.x]); vh[(size_t)t * 256 + threadIdx.x] = __builtin_bit_cast(unsigned short, (_Float16)pr[O_V + threadIdx.x]); }
    if (threadIdx.x < 64) kih[(size_t)t * 64 + threadIdx.x] = __builtin_bit_cast(unsigned short, (_Float16)pr[O_KI + threadIdx.x]);
    if (threadIdx.x < 16) wi[(size_t)t * 16 + threadIdx.x] = pr[O_WI + threadIdx.x];
    const int tl = t % SEQ;
    float y[2]; float ss = 0.f;
#pragma unroll
    for (int i = 0; i < 2; ++i) { const int c = threadIdx.x + i * NT;
        const float* p0 = proj + (size_t)t * DIN;
        float acc = cw[2 * DCONV + c] * (p0[O_CG + c] * p0[O_U + c]);
        if (tl >= 1) { const float* p1 = p0 - DIN; acc += cw[1 * DCONV + c] * (p1[O_CG + c] * p1[O_U + c]); }
        if (tl >= 2) { const float* p2 = p0 - 2 * DIN; acc += cw[0 * DCONV + c] * (p2[O_CG + c] * p2[O_U + c]); }
        y[i] = p0[O_BG + c] * acc; ss += y[i] * y[i]; }
    ss = bsum(ss, red);
    const float rstd = rsqrtf(ss * (1.0f / DCONV) + 1e-6f);
#pragma unroll
    for (int i = 0; i < 2; ++i) { const int c = threadIdx.x + i * NT; merged[(size_t)t * DM + c] = __builtin_bit_cast(unsigned short, (_Float16)(y[i] * rstd * g[c])); }
    __syncthreads();
}

__device__ __forceinline__ void nb_scores(const float* proj, float* scores, int t, unsigned char* lds) {
    float* qi = (float*)lds; float* w = qi + IH * IDIM;
    const int tl = t % SEQ, t0 = t - tl;
    for (int i = threadIdx.x; i < IH * IDIM; i += NT) qi[i] = proj[(size_t)t * DIN + O_QI + i];
    if (threadIdx.x < IH) w[threadIdx.x] = proj[(size_t)t * DIN + O_WI + threadIdx.x];
    __syncthreads();
    for (int s = threadIdx.x; s <= tl; s += NT) {
        const float* kp = proj + (size_t)(t0 + s) * DIN + O_KI;
        float kr[IDIM];
#pragma unroll
        for (int d = 0; d < IDIM; ++d) kr[d] = kp[d];
        float acc = 0.f;
        for (int h = 0; h < IH; ++h) { float dot = 0.f;
#pragma unroll
            for (int d = 0; d < IDIM; ++d) dot += qi[h * IDIM + d] * kr[d];
            acc += w[h] * fmaxf(dot, 0.f); }
        scores[(size_t)t * SEQ + s] = acc;
    }
    __syncthreads();
}

__device__ __forceinline__ void nb_topk(const float* scores, int* sel, int t, unsigned char* lds) {
    unsigned long long* key = (unsigned long long*)lds;
    const int tl = t % SEQ;
    for (int i = threadIdx.x; i < SEQ; i += NT) {
        unsigned long long kv = 0ull;
        if (i <= tl) { unsigned u = __float_as_uint(scores[(size_t)t * SEQ + i]); u = (u & 0x80000000u) ? ~u : (u | 0x80000000u);
            kv = ((unsigned long long)u << 32) | (unsigned)(0xFFFFFFFFu - (unsigned)i); }
        key[i] = kv; }
    __syncthreads();
    for (int k = 2; k <= SEQ; k <<= 1)
        for (int j = k >> 1; j > 0; j >>= 1) {
            for (int i = threadIdx.x; i < SEQ; i += NT) { const int ixj = i ^ j;
                if (ixj > i) { const unsigned long long a = key[i], b = key[ixj]; const bool desc = ((i & k) == 0);
                    if (desc ? (a < b) : (a > b)) { key[i] = b; key[ixj] = a; } } }
            __syncthreads();
        }
    for (int i = threadIdx.x; i < TOPK; i += NT) { const unsigned long long kv = key[i];
        sel[(size_t)t * TOPK + i] = (kv == 0ull) ? -1 : (int)(0xFFFFFFFFu - (unsigned)(kv & 0xFFFFFFFFull)); }
    __syncthreads();
}

__device__ __forceinline__ void nb_attn(const float* proj, const int* sel, const float* g, f16_t* merged, int t, unsigned char* lds) {
    float* red = (float*)lds; float* q = red + 8; float* p = q + NH * HD; float* y = p + TOPK; int* si = (int*)(y + NH * HD);
    const int tl = t % SEQ, t0 = t - tl, tid = threadIdx.x;
    for (int i = tid; i < NH * HD; i += NT) q[i] = proj[(size_t)t * DIN + O_Q + i];
    if (tid < TOPK) { const int s = sel[(size_t)t * TOPK + tid]; si[tid] = (s >= 0 && s <= tl) ? s : -1; }
    __syncthreads();
    const float scale = 0.08838834764831845f;
    for (int h = 0; h < NH; ++h) { const int gk = h / (NH / NKV);
        const int s = (tid < TOPK) ? si[tid] : -1; float logit = -INFINITY;
        if (s >= 0) { const float* kp = proj + (size_t)(t0 + s) * DIN + O_K + gk * HD; float d = 0.f;
            for (int i = 0; i < HD; ++i) d += q[h * HD + i] * kp[i];
            logit = d * scale; }
        const float mx = bmax(logit, red);
        const float ex = (s >= 0) ? expf(logit - mx) : 0.f;
        const float sum = bsum(ex, red);
        if (tid < TOPK) p[tid] = ex / sum;
        __syncthreads();
        if (tid < HD) { float o = 0.f;
            for (int i = 0; i < TOPK; ++i) { const int s2 = si[i]; if (s2 >= 0) o += p[i] * proj[(size_t)(t0 + s2) * DIN + O_V + gk * HD + tid]; }
            y[h * HD + tid] = o; }
        __syncthreads();
    }
    float ss = 0.f;
#pragma unroll
    for (int i = 0; i < 2; ++i) { const float v = y[tid + i * NT]; ss += v * v; }
    ss = bsum(ss, red);
    const float rstd = rsqrtf(ss * (1.0f / (NH * HD)) + 1e-6f);
#pragma unroll
    for (int i = 0; i < 2; ++i) { const int c = tid + i * NT; merged[(size_t)t * DM + DCONV + c] = __builtin_bit_cast(unsigned short, (_Float16)(y[c] * rstd * g[c])); }
    __syncthreads();
}

__device__ __forceinline__ void nb_post_mix(const float* x, const float* mix, const float* gpost, const float* gpre, const float* ada, float* x1, float* h2, f16_t* h2h, int t, unsigned char* lds) {
    float* red = (float*)lds;
    const int bb = t / SEQ; const float* ad = ada + bb * 6 * DM;
    float m[4], xv[4]; float ss = 0.f;
#pragma unroll
    for (int i = 0; i < 4; ++i) { m[i] = mix[(size_t)t * DM + threadIdx.x + i * NT]; ss += m[i] * m[i]; }
    ss = bsum(ss, red);
    const float r1 = rsqrtf(ss * (1.0f / DM) + 1e-6f);
    float s2 = 0.f;
#pragma unroll
    for (int i = 0; i < 4; ++i) { const int c = threadIdx.x + i * NT; xv[i] = x[(size_t)t * DM + c] + ad[A_GT1 + c] * (m[i] * r1 * gpost[c]); s2 += xv[i] * xv[i]; }
    s2 = bsum(s2, red);
    const float r2 = rsqrtf(s2 * (1.0f / DM) + 1e-6f);
#pragma unroll
    for (int i = 0; i < 4; ++i) { const int c = threadIdx.x + i * NT; x1[(size_t)t * DM + c] = xv[i];
        const float hv = xv[i] * r2 * gpre[c] * (1.0f + ad[A_SC2 + c]) + ad[A_SH2 + c];
        h2[(size_t)t * DM + c] = hv; h2h[(size_t)t * DM + c] = __builtin_bit_cast(unsigned short, (_Float16)hv); }
    __syncthreads();
}

__device__ __forceinline__ void nb_router(const float* h2, const float* wr, const float* br, int* topi, float* gate, int vb, unsigned char* lds) {
    float (*lg)[NE] = (float (*)[NE])lds;
    const int tl = threadIdx.x >> 5, e = threadIdx.x & 31, t = vb * 16 + tl;
    const float* hr = h2 + (size_t)t * DM; float acc = 0.f;
    for (int k = 0; k < DM; ++k) acc += hr[k] * wr[k * NE + e];
    lg[tl][e] = acc + br[e];
    __syncthreads();
    if (e == 0) { float v[NE];
#pragma unroll
        for (int i = 0; i < NE; ++i) v[i] = lg[tl][i];
        int idx[TK]; float val[TK];
#pragma unroll
        for (int k = 0; k < TK; ++k) { float best = -INFINITY; int bi = 0;
#pragma unroll
            for (int i = 0; i < NE; ++i) { const bool take = v[i] > best; best = take ? v[i] : best; bi = take ? i : bi; }
            idx[k] = bi; val[k] = best;
#pragma unroll
            for (int i = 0; i < NE; ++i) v[i] = (i == bi) ? -INFINITY : v[i]; }
        float s = 0.f, ex[TK];
#pragma unroll
        for (int k = 0; k < TK; ++k) { ex[k] = expf(val[k] - val[0]); s += ex[k]; }
#pragma unroll
        for (int k = 0; k < TK; ++k) { topi[t * TK + k] = idx[k]; gate[t * TK + k] = ex[k] / s; } }
    __syncthreads();
}

__device__ __forceinline__ void nb_lists(const int* topi, int* lists, int* counts, int* slotpos, int e) {
    const int lane = threadIdx.x & 63; int base = 0;
    for (int f0 = 0; f0 < NROWS; f0 += 64) { const int f = f0 + lane; const bool m = topi[f] == e;
        const unsigned long long mask = __ballot(m);
        const int pos = base + __popcll(mask & ((1ull << lane) - 1ull));
        if (m) { lists[(size_t)e * NTOK + pos] = f; slotpos[f] = pos; }
        base += __popcll(mask); }
    if (lane == 0) counts[e] = base;
}

__device__ __forceinline__ void nb_final(const float* x1, const float* yrows, const int* topi, const float* gate, const int* counts, const int* slotpos, const float* gpost, const float* ada,
                                         float* out, int t, unsigned char* lds) {
    float* red = (float*)lds; int* row = (int*)(red + 8); float* gw = red + 16;
    const int bb = t / SEQ; const float* ad = ada + bb * 6 * DM;
    if (threadIdx.x < TK) { const int f = t * TK + threadIdx.x, e = topi[f]; int st = 0; for (int i = 0; i < e; ++i) st += ((counts[i] + 255) >> 8) << 8;
        row[threadIdx.x] = st + slotpos[f]; gw[threadIdx.x] = gate[f]; }
    __syncthreads();
    float y[4]; float ss = 0.f;
#pragma unroll
    for (int i = 0; i < 4; ++i) { const int c = threadIdx.x + i * NT; float a = 0.f;
#pragma unroll
        for (int k = 0; k < TK; ++k) a += gw[k] * yrows[(size_t)row[k] * DM + c];
        y[i] = a; ss += a * a; }
    ss = bsum(ss, red);
    const float r = rsqrtf(ss * (1.0f / DM) + 1e-6f);
#pragma unroll
    for (int i = 0; i < 4; ++i) { const int c = threadIdx.x + i * NT; out[(size_t)t * DM + c] = x1[(size_t)t * DM + c] + ad[A_GT2 + c] * (y[i] * r * gpost[c]); }
    __syncthreads();
}


typedef float f32x16 __attribute__((ext_vector_type(16)));
__device__ __forceinline__ void ph_scores_pair(const f16_t* qih, const f16_t* kih, const float* wi, float* scores, int t0, int lane) {
    const int r = lane & 31, hi = lane >> 5, tl0 = t0 % SEQ, tb = t0 - tl0;
    const int arow_q = t0 + ((r >> 2) & 1), arow_h = (r & 3) + 4 * (r >> 3);
    f16x8 aq[4];
#pragma unroll
    for (int kk = 0; kk < 4; ++kk) aq[kk] = *(const f16x8*)(qih + (size_t)arow_q * 1024 + arow_h * 64 + kk * 16 + 8 * hi);
    float w[16];
#pragma unroll
    for (int i = 0; i < 4; ++i) { const f32x4 wv = *(const f32x4*)(wi + (size_t)(t0 + hi) * 16 + 4 * i); w[4 * i] = wv[0]; w[4 * i + 1] = wv[1]; w[4 * i + 2] = wv[2]; w[4 * i + 3] = wv[3]; }
    const int ntile = ((tl0 + 1) >> 5) + 1;
    float* orow = scores + (size_t)(t0 + hi) * SEQ + r;
    const f16_t* kp = kih + (size_t)(tb + r) * 64 + 8 * hi;
    f16x8 bk[4][4];
#define SC_LOAD(slot, kt_) do { const int kc_ = ((kt_) < ntile) ? (kt_) : (ntile - 1); _Pragma("unroll") for (int kk = 0; kk < 4; ++kk) bk[slot][kk] = *(const f16x8*)(kp + (size_t)kc_ * 32 * 64 + kk * 16); } while (0)
#define SC_TILE(slot, kt_) do { if ((kt_) < ntile) { f32x16 acc = {0.f, 0.f, 0.f, 0.f, 0.f, 0.f, 0.f, 0.f, 0.f, 0.f, 0.f, 0.f, 0.f, 0.f, 0.f, 0.f}; \
        _Pragma("unroll") for (int kk = 0; kk < 4; ++kk) acc = __builtin_amdgcn_mfma_f32_32x32x16_f16(aq[kk], bk[slot][kk], acc, 0, 0, 0); \
        float sc = 0.f; _Pragma("unroll") for (int i = 0; i < 16; ++i) sc += w[i] * fmaxf(acc[i], 0.f); \
        orow[(kt_) * 32] = sc; } } while (0)
    SC_LOAD(0, 0); SC_LOAD(1, 1); SC_LOAD(2, 2);
    for (int kt = 0; kt < ntile; kt += 4) {
        SC_LOAD(3, kt + 3); SC_TILE(0, kt);
        SC_LOAD(0, kt + 4); SC_TILE(1, kt + 1);
        SC_LOAD(1, kt + 5); SC_TILE(2, kt + 2);
        SC_LOAD(2, kt + 6); SC_TILE(3, kt + 3);
    }
#undef SC_LOAD
#undef SC_TILE
}


__device__ __forceinline__ void ph_scores_block(const f16_t* qih, const f16_t* kih, const float* wi, float* scores, int tq0, LAS unsigned char* lds) {
    const int tid = threadIdx.x, lane = tid & 63, wv = __builtin_amdgcn_readfirstlane(tid >> 6), r = lane & 31, hi = lane >> 5;
    const int t0 = tq0 + 2 * wv, tl0 = t0 % SEQ, tb = t0 - tl0, tlmax = (tq0 % SEQ) + 15;
    const int arow_q = t0 + ((r >> 2) & 1), arow_h = (r & 3) + 4 * (r >> 3);
    f16x8 aq[4];
#pragma unroll
    for (int kk = 0; kk < 4; ++kk) aq[kk] = *(const f16x8*)(qih + (size_t)arow_q * 1024 + arow_h * 64 + kk * 16 + 8 * hi);
    float w[16];
#pragma unroll
    for (int i = 0; i < 4; ++i) { const f32x4 wvv = *(const f32x4*)(wi + (size_t)(t0 + hi) * 16 + 4 * i); w[4 * i] = wvv[0]; w[4 * i + 1] = wvv[1]; w[4 * i + 2] = wvv[2]; w[4 * i + 3] = wvv[3]; }
    const int nchunk = (tlmax >> 8) + 1;
    float* orow = scores + (size_t)(t0 + hi) * SEQ + r;
    const u32x4* gsrc = (const u32x4*)(kih + (size_t)tb * 64) + tid;
    u32x4 st[4];
#define SCB_WRITE(buf) do { _Pragma("unroll") for (int i = 0; i < 4; ++i) { const int q = tid + 512 * i; *(LAS u32x4*)(lds + (buf) * 36864 + (q >> 3) * 144 + (q & 7) * 16) = st[i]; } } while (0)
#pragma unroll
    for (int i = 0; i < 4; ++i) st[i] = gsrc[512 * i];
    SCB_WRITE(0);
    __syncthreads();
    for (int c = 0; c < nchunk; ++c) {
        if (c + 1 < nchunk) {
#pragma unroll
            for (int i = 0; i < 4; ++i) st[i] = gsrc[(size_t)(c + 1) * 2048 + 512 * i]; }
        const LAS unsigned char* kb = lds + (c & 1) * 36864 + r * 144 + hi * 16;
#pragma unroll
        for (int kt = 0; kt < 8; ++kt) { const int s0 = c * 256 + kt * 32;
            if (s0 <= tl0 + 1) {
                f32x16 acc = {0.f, 0.f, 0.f, 0.f, 0.f, 0.f, 0.f, 0.f, 0.f, 0.f, 0.f, 0.f, 0.f, 0.f, 0.f, 0.f};
#pragma unroll
                for (int kk = 0; kk < 4; ++kk) acc = __builtin_amdgcn_mfma_f32_32x32x16_f16(aq[kk], *(const LAS f16x8*)(kb + kt * 32 * 144 + kk * 32), acc, 0, 0, 0);
                float sc = 0.f;
#pragma unroll
                for (int i = 0; i < 16; ++i) sc += w[i] * fmaxf(acc[i], 0.f);
                orow[s0] = sc; } }
        if (c + 1 < nchunk) SCB_WRITE((c + 1) & 1);
        __syncthreads();
    }
#undef SCB_WRITE
}

__device__ __forceinline__ void ph_select_row(const float* scores, unsigned long long* mask, int t, int lane) {
    const int tl = t % SEQ, n = tl + 1, nj = (n + 63) >> 6;
    const float* srow = scores + (size_t)t * SEQ;
    unsigned key[64];
#pragma unroll
    for (int g16 = 0; g16 < 4; ++g16) {
        if (g16 * 16 < nj) { float sv[16];
#pragma unroll
            for (int jj = 0; jj < 16; ++jj) { const int idx = (g16 * 16 + jj) * 64 + lane; sv[jj] = srow[idx <= tl ? idx : tl]; }
#pragma unroll
            for (int jj = 0; jj < 16; ++jj) { const int idx = (g16 * 16 + jj) * 64 + lane; unsigned u = __float_as_uint(sv[jj]); u = (u & 0x80000000u) ? ~u : (u | 0x80000000u);
                key[g16 * 16 + jj] = (idx <= tl) ? u : 0u; } }
        else {
#pragma unroll
            for (int jj = 0; jj < 16; ++jj) key[g16 * 16 + jj] = 0u; } }
    unsigned long long* mrow = mask + (size_t)t * 64;
    if (n <= TOPK) {
#pragma unroll
        for (int j = 0; j < 64; ++j) { const unsigned long long m = (j < nj) ? __ballot(j * 64 + lane <= tl) : 0ull; if (lane == 0) mrow[j] = m; }
        return;
    }
    unsigned T = 0u; bool exact = false;
    for (int bit = 31; bit >= 0; --bit) { const unsigned cand = T | (1u << bit); int cl = 0;
#pragma unroll
        for (int g16 = 0; g16 < 4; ++g16) if (g16 * 16 < nj) {
#pragma unroll
            for (int jj = 0; jj < 16; ++jj) cl += (key[g16 * 16 + jj] >= cand) ? 1 : 0; }
        cl += __builtin_amdgcn_update_dpp(0, cl, 0xb1, 0xf, 0xf, false);
        cl += __builtin_amdgcn_update_dpp(0, cl, 0x4e, 0xf, 0xf, false);
        cl += __builtin_amdgcn_update_dpp(0, cl, 0x124, 0xf, 0xf, false);
        cl += __builtin_amdgcn_update_dpp(0, cl, 0x128, 0xf, 0xf, false);
        cl += __builtin_amdgcn_update_dpp(0, cl, 0x142, 0xa, 0xf, false);
        cl += __builtin_amdgcn_update_dpp(0, cl, 0x143, 0xc, 0xf, false);
        const int cnt = __builtin_amdgcn_readlane(cl, 63);
        if (cnt >= TOPK) T = cand;
        if (cnt == TOPK) { exact = true; break; } }
    int cgt = 0;
    if (exact) { cgt = TOPK; if (T > 0u) T -= 1u; }
    else {
#pragma unroll
        for (int j = 0; j < 64; ++j) if (j < nj) cgt += __popcll(__ballot(key[j] > T)); }
    int need = TOPK - cgt;
#pragma unroll
    for (int j = 0; j < 64; ++j) { unsigned long long m = 0ull;
        if (j < nj) { unsigned long long eq = __ballot(key[j] == T); const unsigned long long gt = __ballot(key[j] > T);
            int c = __popcll(eq);
            while (c > need) { eq &= ~(1ull << (63 - __clzll((long long)eq))); --c; }
            need -= c; m = gt | eq;
            }
        if (lane == 0) mrow[j] = m; }
}


namespace att {
constexpr int D = 128, QS = 1024, KVS = 256;
constexpr float SCALE = 0.08838834764831845f, THR = 8.f;
constexpr int NW = 8, QBLK = 32, KVBLK = 64, QB = NW * QBLK;
constexpr int SHM_V = KVBLK * D * 2, SHM_K = KVBLK * D * 2;
constexpr int ATT_LDS_BYTES = 2 * SHM_V + 2 * SHM_K + NW * 64 * 4;
typedef short bf16x8 __attribute__((ext_vector_type(8)));
typedef short s16x4 __attribute__((ext_vector_type(4)));
#define ATT_MFMA(a, b, c) __builtin_amdgcn_mfma_f32_32x32x16_f16(__builtin_bit_cast(f16x8, a), __builtin_bit_cast(f16x8, b), c, 0, 0, 0)
#define KSWZ(row, colB) ((row) * 256 + ((colB) ^ (((row) & 7) << 4)))
#define SBAR() __builtin_amdgcn_sched_barrier(0)
__device__ __forceinline__ int v_st(int k, int c) { const int kk = (k & ~0xC) | ((k & 4) << 1) | ((k & 8) >> 1); return ((kk >> 3) * 4 + (c >> 5)) * 512 + ((kk & 7) * 32 + (c & 31)) * 2; }
__device__ __forceinline__ int v_rd_base(int lane) { return ((lane & 3) << 3) | (((lane >> 2) & 3) << 6) | (((lane >> 4) & 1) << 5) | (((lane >> 5) & 1) << 8); }
constexpr int v_rd_off(int d0, int ks, int half) { return d0 * 512 + ks * 4096 + half * 2048; }
__device__ __forceinline__ int crow(int r, int hi) { return (r & 3) + 8 * (r >> 2) + 4 * hi; }
__device__ __forceinline__ unsigned cvtpk(float lo, float hi) { unsigned r; asm volatile("v_cvt_pk_f16_f32 %0, %1, %2" : "=v"(r) : "v"(lo), "v"(hi)); return r; }
__device__ __forceinline__ bf16x8 load8(const f16_t* p) { return *reinterpret_cast<const bf16x8*>(p); }
__device__ __forceinline__ void mask_bits(f32x16& p0, f32x16& p1, unsigned lo, unsigned hiw, int hi) {
    const float NEG = -__builtin_inff();
    const unsigned l = lo >> (4 * hi), h = hiw >> (4 * hi);
#pragma unroll
    for (int r = 0; r < 16; ++r) {
        const int c = (r & 3) + 8 * (r >> 2);
        if (((l >> c) & 1u) == 0u) p0[r] = NEG;
        if (((h >> c) & 1u) == 0u) p1[r] = NEG;
    }
}
__device__ __forceinline__ void partialSM(f32x16& p0, f32x16& p1, float& m_reg, float& mn, float& alpha) {
    float pmax = p0[0]; for (int r = 1; r < 16; ++r) pmax = fmaxf(pmax, p0[r]); for (int r = 0; r < 16; ++r) pmax = fmaxf(pmax, p1[r]);
    { auto rr = __builtin_amdgcn_permlane32_swap(__float_as_uint(pmax), __float_as_uint(pmax), false, false);
      pmax = fmaxf(__uint_as_float(rr[0]), __uint_as_float(rr[1])); }
    constexpr float C2 = 1.4426950408889634f * SCALE;
    if (__builtin_expect(__all((pmax - m_reg) * SCALE <= THR), 1)) { mn = m_reg; alpha = 1.f; }
    else { mn = fmaxf(m_reg, pmax); alpha = __builtin_amdgcn_exp2f((m_reg - mn) * C2); m_reg = mn; }
    const float mnL = -mn * C2;
    for (int r = 0; r < 16; ++r) p0[r] = fmaf(p0[r], C2, mnL); for (int r = 0; r < 16; ++r) p1[r] = fmaf(p1[r], C2, mnL);
    for (int r = 0; r < 16; ++r) p0[r] = __builtin_amdgcn_exp2f(p0[r]);
}
__device__ __forceinline__ void finishSM(f32x16& p0, f32x16& p1, float alpha, float& l_reg, bf16x8& pa0, bf16x8& pa1, bf16x8& pa2, bf16x8& pa3) {
    for (int r = 0; r < 16; ++r) p1[r] = __builtin_amdgcn_exp2f(p1[r]);
    float ps = 0; for (int r = 0; r < 16; ++r) ps += p0[r]; for (int r = 0; r < 16; ++r) ps += p1[r];
    { auto rr = __builtin_amdgcn_permlane32_swap(__float_as_uint(ps), __float_as_uint(ps), false, false);
      ps = __uint_as_float(rr[0]) + __uint_as_float(rr[1]); }
    l_reg = l_reg * alpha + ps;
#define PK4(P, B_, OUT) do { unsigned a0 = cvtpk(P[B_+0], P[B_+1]), a1 = cvtpk(P[B_+2], P[B_+3]);                          \
        unsigned b0 = cvtpk(P[B_+4], P[B_+5]), b1 = cvtpk(P[B_+6], P[B_+7]);                                             \
        auto r0 = __builtin_amdgcn_permlane32_swap(a0, b0, false, false); auto r1 = __builtin_amdgcn_permlane32_swap(a1, b1, false, false); \
        u32x4 w = {r0[0], r1[0], r0[1], r1[1]}; OUT = *reinterpret_cast<bf16x8*>(&w); } while (0)
    PK4(p0, 0, pa0); PK4(p0, 8, pa1); PK4(p1, 0, pa2); PK4(p1, 8, pa3);
#undef PK4
}
template <int KB>
__device__ __forceinline__ void qkt(f32x16& p0, f32x16& p1, const char* K_lds, int r32, int hi, const bf16x8* qr) {
    p0 = f32x16{}; p1 = f32x16{};
    const char* kb[4];
#pragma unroll
    for (int dd = 0; dd < 4; ++dd) kb[dd] = K_lds + KB * SHM_K + KSWZ(r32, (dd * 16 + hi * 8) * 2);
#pragma unroll
    for (int d0 = 0; d0 < 8; ++d0) { const char* a = kb[d0 & 3] + (d0 >> 2) * 128;
        bf16x8 b0 = *reinterpret_cast<const bf16x8*>(a);
        bf16x8 b1 = *reinterpret_cast<const bf16x8*>(a + 32 * 256);
        p0 = ATT_MFMA(b0, qr[d0], p0);
        p1 = ATT_MFMA(b1, qr[d0], p1); }
}
template <int VB>
__device__ __forceinline__ void pv_tile(f32x16* o, int vb0, bf16x8 pa0, bf16x8 pa1, bf16x8 pa2, bf16x8 pa3) {
#define TRRD(dst, off) asm volatile("ds_read_b64_tr_b16 %0, %1 offset:%2" : "=&v"(dst) : "v"(vb0), "i"(off) : "memory")
#define PV_D0(d0) do { s16x4 l0, l1, l2, l3, h0, h1, h2, h3; constexpr int b_ = VB * SHM_V + v_rd_off(d0, 0, 0); \
        TRRD(l0, b_); TRRD(h0, b_ + 2048); TRRD(l1, b_ + 4096); TRRD(h1, b_ + 6144); TRRD(l2, b_ + 8192); TRRD(h2, b_ + 10240); TRRD(l3, b_ + 12288); TRRD(h3, b_ + 14336); \
        asm volatile("s_waitcnt lgkmcnt(0)" ::: "memory"); SBAR();   \
        o[d0] = ATT_MFMA(pa0, ((bf16x8){l0[0], l0[1], l0[2], l0[3], h0[0], h0[1], h0[2], h0[3]}), o[d0]);   \
        o[d0] = ATT_MFMA(pa1, ((bf16x8){l1[0], l1[1], l1[2], l1[3], h1[0], h1[1], h1[2], h1[3]}), o[d0]);   \
        o[d0] = ATT_MFMA(pa2, ((bf16x8){l2[0], l2[1], l2[2], l2[3], h2[0], h2[1], h2[2], h2[3]}), o[d0]);   \
        o[d0] = ATT_MFMA(pa3, ((bf16x8){l3[0], l3[1], l3[2], l3[3], h3[0], h3[1], h3[2], h3[3]}), o[d0]); } while (0)
    PV_D0(0); PV_D0(1); PV_D0(2); PV_D0(3);
#undef PV_D0
#undef TRRD
}

struct BlockRef { const f16_t* Q; const f16_t* K; const f16_t* V; const unsigned long long* M; f16_t* O; float* ST; int j_lo, j_hi; };
struct Seam { bf16x8 qr[8]; bf16x8 st_v0, st_v1, st_k0, st_k1; };
#define ROWOFF(k0, rr) ((unsigned)((((k0) + (rr)) * KVS + sc) * 2))
#define LD8(base, off) (*reinterpret_cast<const bf16x8*>((const char*)(base) + (off)))
#define VMW() asm volatile("s_waitcnt vmcnt(0)" ::: "memory")
#define VMWN(n) asm volatile("s_waitcnt vmcnt(%0)" :: "i"(n) : "memory")
#define SLOAD_H(Kp, Vp, k0) do { S.st_v0 = LD8(Vp, ROWOFF(k0, sr)); S.st_v1 = LD8(Vp, ROWOFF(k0, 32 + sr));              \
                         S.st_k0 = LD8(Kp, ROWOFF(k0, sr)); S.st_k1 = LD8(Kp, ROWOFF(k0, 32 + sr)); } while (0)
#define SWRITE_HK(bf) do { *(bf16x8*)(K_lds + (bf) * SHM_K + kws) = S.st_k0; *(bf16x8*)(K_lds + (bf) * SHM_K + kws + 32 * 256) = S.st_k1; } while (0)
#define SWRITE_HV(bf) do { *(bf16x8*)(V_lds + (bf) * SHM_V + vst0) = S.st_v0; *(bf16x8*)(V_lds + (bf) * SHM_V + vst1) = S.st_v1; } while (0)
#define SWRITE_H(bf) do { SWRITE_HV(bf); SWRITE_HK(bf); } while (0)
__device__ __forceinline__ void attn_block(const BlockRef& cur, char* lds) {
    const int tid = threadIdx.x, wid = __builtin_amdgcn_readfirstlane(tid >> 6), lane = tid & 63, r32 = lane & 31, hi = lane >> 5;
    const int j_lo = cur.j_lo, NTL = cur.j_hi - cur.j_lo;
    char* V_lds = lds; char* K_lds = lds + 2 * SHM_V;
    float* ws = (float*)(lds + 2 * SHM_V + 2 * SHM_K) + wid * 64; float* li_l = ws, * al_l = ws + 32;
    float m_reg = -1e30f, l_reg = 0; f32x16 o[4] = {};
    const int sr = tid >> 4, sc = (tid & 15) * 8, vst0 = v_st(sr, sc), vst1 = v_st(32 + sr, sc), kws = KSWZ(sr, sc * 2);
    const int vb0 = (int)(uintptr_t)V_lds + v_rd_base(lane);
    const f16_t* Kh = cur.K; const f16_t* Vh = cur.V;
    Seam S;
#define MROW(t_) (*(const unsigned long long*)((const char*)cur.M + (unsigned)((((wid * QBLK + r32) * 64) + j_lo + (t_)) * 8)))
#define RESC(a) do { if (__any((a) < 1.f)) { if (hi == 0) al_l[r32] = (a); asm volatile("s_waitcnt lgkmcnt(0)" ::: "memory");              \
                     for (int d_ = 0; d_ < 4; ++d_) for (int r = 0; r < 16; ++r) o[d_][r] *= al_l[crow(r, hi)]; } } while (0)
#define KBASE(t) ((j_lo + (t)) * KVBLK)
#define MASKW(P0_, P1_, mw_) mask_bits(P0_, P1_, (unsigned)(mw_), (unsigned)((mw_) >> 32), hi)
#pragma unroll
    for (int d0 = 0; d0 < 8; ++d0) S.qr[d0] = *reinterpret_cast<const bf16x8*>((const char*)cur.Q + (unsigned)(((wid * QBLK + r32) * QS + d0 * 16 + hi * 8) * 2));
    SLOAD_H(Kh, Vh, KBASE(0)); VMW(); SWRITE_H(0);
    __syncthreads();
    f32x16 p0, p1; float mn, al; bf16x8 pa0, pa1, pa2, pa3; unsigned long long mw;
#define STEP(t, CB, NBUF) do {                                                                                                \
        mw = MROW(t); SBAR();                                                                                                 \
        if ((t) + 1 < NTL) { SLOAD_H(Kh, Vh, KBASE((t) + 1)); SBAR(); }                                                       \
        qkt<CB>(p0, p1, K_lds, r32, hi, S.qr);                                                                                \
        MASKW(p0, p1, mw); partialSM(p0, p1, m_reg, mn, al); finishSM(p0, p1, al, l_reg, pa0, pa1, pa2, pa3);                 \
        RESC(al); SBAR();                                                                                                     \
        pv_tile<CB>(o, vb0, pa0, pa1, pa2, pa3);                                                                              \
        if ((t) + 1 < NTL) { VMW(); SWRITE_H(NBUF); }                                                                         \
        __syncthreads(); } while (0)
    for (int t = 0; t < NTL; t += 2) { STEP(t, 0, 1); STEP(t + 1, 1, 0); }
    if (hi == 0) { li_l[r32] = l_reg; *(float2*)(cur.ST + (size_t)(wid * QBLK + r32) * 16) = make_float2(m_reg, l_reg); }
    asm volatile("s_waitcnt lgkmcnt(0)" ::: "memory");
    float rli[16];
#pragma unroll
    for (int r = 0; r < 16; ++r) { const float lv = li_l[crow(r, hi)]; rli[r] = lv > 0.f ? __builtin_amdgcn_rcpf(lv) : 0.f; }
    f16_t* Ow = cur.O + (size_t)(wid * QBLK) * QS;
#pragma unroll
    for (int r = 0; r < 16; ++r) { const int orow = crow(r, hi);
#pragma unroll
        for (int d0 = 0; d0 < 4; ++d0) { const float v = o[d0][r] * rli[r];
            const float vn = __shfl_xor(v, 1);
            if ((r32 & 1) == 0) *(unsigned*)(Ow + (size_t)orow * QS + d0 * 32 + r32) = cvtpk(v, vn); } }
    __syncthreads();
#undef RESC
#undef KBASE
#undef MROW
#undef MASKW
#undef STEP
}
#undef ROWOFF
#undef LD8
#undef VMW
#undef VMWN
#undef SLOAD_H
#undef SWRITE_HK
#undef SWRITE_HV
#undef SWRITE_H
#undef KSWZ
#undef SBAR
}

__device__ __forceinline__ float wsum_dpp(float v) {
    int x = __float_as_int(v);
#define WS_STEP(ctrl, rmask) x = __float_as_int(__int_as_float(x) + __int_as_float(__builtin_amdgcn_update_dpp(0, x, ctrl, rmask, 0xf, false)))
    WS_STEP(0xb1, 0xf); WS_STEP(0x4e, 0xf); WS_STEP(0x124, 0xf); WS_STEP(0x128, 0xf); WS_STEP(0x142, 0xa); WS_STEP(0x143, 0xc);
#undef WS_STEP
    return __int_as_float(__builtin_amdgcn_readlane(x, 63));
}
__device__ __forceinline__ att::BlockRef att_ref_sorted(int k, const f16_t* qh, const f16_t* kh, const f16_t* vh, const unsigned long long* maskp, f16_t* opart, float* ostat) {
    const int qb = 15 - (k >> 5), w = k & 31, bh = w >> 1, s = w & 1, b = bh >> 3, h = bh & 7;
    const int tok0 = b * SEQ + qb * 256, g = h >> 2;
    att::BlockRef R;
    R.Q = qh + (size_t)tok0 * 1024 + h * 128;
    R.K = kh + (size_t)(b * SEQ) * 256 + g * 128;
    R.V = vh + (size_t)(b * SEQ) * 256 + g * 128;
    R.M = maskp + (size_t)tok0 * 64;
    R.O = opart + ((size_t)s * NTOK + tok0) * 1024 + h * 128;
    R.ST = ostat + (((size_t)s * NTOK + tok0) * 8 + h) * 2;
    R.j_lo = s ? 2 * (qb + 1) : 0; R.j_hi = s ? 4 * (qb + 1) : 2 * (qb + 1);
    return R;
}
__device__ __forceinline__ att::BlockRef att_ref(int idx, const f16_t* qh, const f16_t* kh, const f16_t* vh, const unsigned long long* maskp, f16_t* opart, float* ostat) {
    const int item = idx >> 1, which = idx & 1;
    const int bh = item >> 4, b = bh >> 3, h = bh & 7, r = item & 15, p = r >> 1, s = r & 1;
    const int qb = which ? 15 - p : p;
    const int tok0 = b * SEQ + qb * 256, g = h >> 2;
    att::BlockRef R;
    R.Q = qh + (size_t)tok0 * 1024 + h * 128;
    R.K = kh + (size_t)(b * SEQ) * 256 + g * 128;
    R.V = vh + (size_t)(b * SEQ) * 256 + g * 128;
    R.M = maskp + (size_t)tok0 * 64;
    R.O = opart + ((size_t)s * NTOK + tok0) * 1024 + h * 128;
    R.ST = ostat + (((size_t)s * NTOK + tok0) * 8 + h) * 2;
    R.j_lo = s ? 2 * (qb + 1) : 0; R.j_hi = s ? 4 * (qb + 1) : 2 * (qb + 1);
    return R;
}
__device__ __forceinline__ void ph_merge_rows4(const f16_t* opart, const float* ostat, const float* g, f16_t* merged, int t0, int tstride, int lane) {
    const int h = lane >> 3; constexpr float C2 = 1.4426950408889634f * att::SCALE;
    float gv[16];
#pragma unroll
    for (int i = 0; i < 4; ++i) { const f32x4 q = *(const f32x4*)(g + 16 * lane + 4 * i); gv[4 * i] = q[0]; gv[4 * i + 1] = q[1]; gv[4 * i + 2] = q[2]; gv[4 * i + 3] = q[3]; }
    float2 s0[4], s1[4]; f16x8 u[4][2], v[4][2];
#pragma unroll
    for (int r = 0; r < 4; ++r) { const int t = t0 + r * tstride;
        s0[r] = *(const float2*)(ostat + ((size_t)t * 8 + h) * 2); s1[r] = *(const float2*)(ostat + (((size_t)NTOK + t) * 8 + h) * 2);
        const f16x8* p0 = (const f16x8*)(opart + (size_t)t * 1024 + 16 * lane); const f16x8* p1 = (const f16x8*)(opart + ((size_t)NTOK + t) * 1024 + 16 * lane);
        u[r][0] = p0[0]; u[r][1] = p0[1]; v[r][0] = p1[0]; v[r][1] = p1[1]; }
#pragma unroll
    for (int r = 0; r < 4; ++r) { const int t = t0 + r * tstride;
        const float M = fmaxf(s0[r].x, s1[r].x);
        float a0 = s0[r].y * __builtin_amdgcn_exp2f((s0[r].x - M) * C2), a1 = s1[r].y * __builtin_amdgcn_exp2f((s1[r].x - M) * C2);
        const float inv = 1.0f / (a0 + a1); a0 *= inv; a1 *= inv;
        float y[16]; float ss = 0.f;
#pragma unroll
        for (int q = 0; q < 2; ++q)
#pragma unroll
            for (int i = 0; i < 8; ++i) { const float yy = a0 * (float)u[r][q][i] + a1 * (float)v[r][q][i]; y[q * 8 + i] = yy; ss += yy * yy; }
        const float rstd = rsqrtf(wsum_dpp(ss) * (1.0f / 1024.0f) + 1e-6f);
        u32x4 w0, w1;
        w0.x = pk2h(y[0] * rstd * gv[0], y[1] * rstd * gv[1]); w0.y = pk2h(y[2] * rstd * gv[2], y[3] * rstd * gv[3]); w0.z = pk2h(y[4] * rstd * gv[4], y[5] * rstd * gv[5]); w0.w = pk2h(y[6] * rstd * gv[6], y[7] * rstd * gv[7]);
        w1.x = pk2h(y[8] * rstd * gv[8], y[9] * rstd * gv[9]); w1.y = pk2h(y[10] * rstd * gv[10], y[11] * rstd * gv[11]); w1.z = pk2h(y[12] * rstd * gv[12], y[13] * rstd * gv[13]); w1.w = pk2h(y[14] * rstd * gv[14], y[15] * rstd * gv[15]);
        u32x4* dst = (u32x4*)(merged + (size_t)t * DM + DCONV + 16 * lane); dst[0] = w0; dst[1] = w1; }
}

__device__ __forceinline__ float wsum(float v) { return wsum_dpp(v); }
__device__ __forceinline__ void ph_h1_row(const float* x, const LAS float* tab, f16_t* out, int t, int lane) {
    const f32x4* xr = (const f32x4*)(x + (size_t)t * DM) + lane;
    f32x4 v[8]; float ss = 0.f;
#pragma unroll
    for (int j = 0; j < 8; ++j) { v[j] = xr[64 * j]; ss += (v[j][0] * v[j][0] + v[j][1] * v[j][1]) + (v[j][2] * v[j][2] + v[j][3] * v[j][3]); }
    const float rstd = rsqrtf(wsum(ss) * (1.0f / DM) + 1e-6f);
    const LAS f32x4* ta = (const LAS f32x4*)(tab + (t / SEQ) * 2 * DM) + lane; const LAS f32x4* tb = ta + DM / 4;
    u32x2* o = (u32x2*)(out + (size_t)t * DM) + lane;
#pragma unroll
    for (int j = 0; j < 8; ++j) { const f32x4 a = ta[64 * j], b = tb[64 * j]; const f32x4 h = v[j] * rstd * a + b;
        u32x2 w; w.x = pk2h(h[0], h[1]); w.y = pk2h(h[2], h[3]); o[64 * j] = w; }
}
__device__ __forceinline__ void rope32_chunk(float (&v)[16], int chunk, const float (&cs)[16], const float (&sn)[16]) {
#pragma unroll
    for (int j = 0; j < 16; ++j) { const float other = __shfl_xor(v[j], 1);
        if (chunk == 0) v[j] = v[j] * cs[j] - other * sn[j];
        else if (chunk == 1) v[j] = v[j] * cs[j] + other * sn[j]; }
}
__device__ __forceinline__ void ld16(const float* p, float (&v)[16]) {
#pragma unroll
    for (int i = 0; i < 4; ++i) { const f32x4 q = *(const f32x4*)(p + 4 * i); v[4 * i] = q[0]; v[4 * i + 1] = q[1]; v[4 * i + 2] = q[2]; v[4 * i + 3] = q[3]; }
}
__device__ __forceinline__ void ld16(const f16_t* p, float (&v)[16]) {
    const f16x8 a = ((const f16x8*)p)[0], b = ((const f16x8*)p)[1];
#pragma unroll
    for (int i = 0; i < 8; ++i) { v[i] = (float)a[i]; v[8 + i] = (float)b[i]; }
}
struct Raw16 { f16x8 a, b; };
__device__ __forceinline__ Raw16 ld16raw(const f16_t* p) { Raw16 r; r.a = ((const f16x8*)p)[0]; r.b = ((const f16x8*)p)[1]; return r; }
__device__ __forceinline__ void cvt16(const Raw16& r, float (&v)[16]) {
#pragma unroll
    for (int i = 0; i < 8; ++i) { v[i] = (float)r.a[i]; v[8 + i] = (float)r.b[i]; }
}
__device__ __forceinline__ void st16h(f16_t* p, const float (&v)[16]) {
    u32x4 a, b; a.x = pk2h(v[0], v[1]); a.y = pk2h(v[2], v[3]); a.z = pk2h(v[4], v[5]); a.w = pk2h(v[6], v[7]);
    b.x = pk2h(v[8], v[9]); b.y = pk2h(v[10], v[11]); b.z = pk2h(v[12], v[13]); b.w = pk2h(v[14], v[15]);
    ((u32x4*)p)[0] = a; ((u32x4*)p)[1] = b;
}
__device__ __forceinline__ void ph_rope_conv_row(const f16_t* proj, const int* positions, const float* cw, const float* g, f16_t* merged, f16_t* qh, f16_t* kh, f16_t* vh, f16_t* qih, f16_t* kih, float* wi, int t, int lane) {
    const f16_t* pr = proj + (size_t)t * DIN; const int pos = positions[t];
    const int tl = t % SEQ, c0 = 16 * lane;
    const Raw16 rq = ld16raw(pr + O_Q + 16 * lane);
    const Raw16 rkv = ld16raw(pr + ((lane < 16) ? O_K : O_V) + 16 * (lane & 15));
    const Raw16 rqi = ld16raw(pr + O_QI + 16 * lane);
    const Raw16 rki = ld16raw(pr + ((lane < 4) ? (O_KI + 16 * lane) : O_WI));
    const Raw16 rcg0 = ld16raw(pr + O_CG + c0), ru0 = ld16raw(pr + O_U + c0);
    const f16_t* pr1 = (tl >= 1) ? pr - DIN : pr; const f16_t* pr2 = (tl >= 2) ? pr - 2 * DIN : pr;
    const Raw16 rcg1 = ld16raw(pr1 + O_CG + c0), ru1 = ld16raw(pr1 + O_U + c0);
    const Raw16 rcg2 = ld16raw(pr2 + O_CG + c0), ru2 = ld16raw(pr2 + O_U + c0);
    const Raw16 rbg = ld16raw(pr + O_BG + c0);
    float cmine, smine; rope_cs(pos, c_invf16[lane & 15], cmine, smine);
    float cs[16], sn[16];
#pragma unroll
    for (int j = 0; j < 16; ++j) { cs[j] = __shfl(cmine, j); sn[j] = __shfl(smine, j); }
    float v[16];
    cvt16(rq, v); rope32_chunk(v, lane & 7, cs, sn); st16h(qh + (size_t)t * 1024 + 16 * lane, v);
    { const int l2 = lane & 15; cvt16(rkv, v); rope32_chunk(v, (lane < 16) ? (lane & 7) : 2, cs, sn);
      if (lane < 32) st16h(((lane < 16) ? kh : vh) + (size_t)t * 256 + 16 * l2, v); }
    cvt16(rqi, v);
    if ((lane & 3) == 0) {
#pragma unroll
        for (int j = 0; j < 8; ++j) { const float a = v[j], b = v[j + 8]; v[j] = a * cs[2 * j] - b * sn[2 * j]; v[j + 8] = b * cs[2 * j] + a * sn[2 * j]; } }
    st16h(qih + (size_t)t * 1024 + 16 * lane, v);
    cvt16(rki, v);
    if (lane == 0) {
#pragma unroll
        for (int j = 0; j < 8; ++j) { const float a = v[j], b = v[j + 8]; v[j] = a * cs[2 * j] - b * sn[2 * j]; v[j + 8] = b * cs[2 * j] + a * sn[2 * j]; } }
    if (lane < 4) st16h(kih + (size_t)t * 64 + 16 * lane, v);
    if (lane == 4) {
#pragma unroll
        for (int i = 0; i < 4; ++i) *(f32x4*)(wi + (size_t)t * 16 + 4 * i) = (f32x4){v[4 * i], v[4 * i + 1], v[4 * i + 2], v[4 * i + 3]}; }
    float cg[16], u[16], y[16];
    cvt16(rcg0, cg); cvt16(ru0, u); ld16(cw + 2 * DCONV + c0, v);
#pragma unroll
    for (int i = 0; i < 16; ++i) y[i] = v[i] * (cg[i] * u[i]);
    if (tl >= 1) { cvt16(rcg1, cg); cvt16(ru1, u); ld16(cw + 1 * DCONV + c0, v);
#pragma unroll
        for (int i = 0; i < 16; ++i) y[i] += v[i] * (cg[i] * u[i]); }
    if (tl >= 2) { cvt16(rcg2, cg); cvt16(ru2, u); ld16(cw + c0, v);
#pragma unroll
        for (int i = 0; i < 16; ++i) y[i] += v[i] * (cg[i] * u[i]); }
    cvt16(rbg, v); float ss = 0.f;
#pragma unroll
    for (int i = 0; i < 16; ++i) { y[i] *= v[i]; ss += y[i] * y[i]; }
    const float rstd = rsqrtf(wsum(ss) * (1.0f / DCONV) + 1e-6f);
    ld16(g + c0, v);
#pragma unroll
    for (int i = 0; i < 16; ++i) y[i] = y[i] * rstd * v[i];
    st16h(merged + (size_t)t * DM + c0, y);
}
__device__ __forceinline__ void ph_post_row(const float* x, const f16_t* mix, const LAS float* tab, float* x1, LAS float* rs2, unsigned char* h2q, int t, int lane) {
    const u32x2* mr = (const u32x2*)(mix + (size_t)t * DM) + lane; const f32x4* xr = (const f32x4*)(x + (size_t)t * DM) + lane;
    const LAS f32x4* t0 = (const LAS f32x4*)tab + lane;
    f32x4 m[8]; float ss = 0.f;
#pragma unroll
    for (int j = 0; j < 8; ++j) { const u32x2 mh = mr[64 * j];
        m[j] = (f32x4){__uint_as_float(mh.x << 16), __uint_as_float(mh.x & 0xFFFF0000u), __uint_as_float(mh.y << 16), __uint_as_float(mh.y & 0xFFFF0000u)}; ss += (m[j][0] * m[j][0] + m[j][1] * m[j][1]) + (m[j][2] * m[j][2] + m[j][3] * m[j][3]); }
    const float r1 = rsqrtf(wsum(ss) * (1.0f / DM) + 1e-6f);
    float s2 = 0.f;
#pragma unroll
    for (int j = 0; j < 8; ++j) { m[j] = xr[64 * j] + t0[64 * j] * (m[j] * r1 * t0[64 * j + DM / 4]); s2 += (m[j][0] * m[j][0] + m[j][1] * m[j][1]) + (m[j][2] * m[j][2] + m[j][3] * m[j][3]); }
    const float r2 = rsqrtf(wsum(s2) * (1.0f / DM) + 1e-6f);
    f32x4* xo = (f32x4*)(x1 + (size_t)t * DM) + lane; unsigned* hq = (unsigned*)(h2q + (size_t)t * DM) + lane;
    if (lane == 0) *rs2 = r2;
#pragma unroll
    for (int j = 0; j < 8; ++j) { xo[64 * j] = m[j]; const f32x4 h = m[j] * r2 * t0[64 * j + 2 * (DM / 4)] + t0[64 * j + 3 * (DM / 4)];
        hq[64 * j] = pk4q(h[0], h[1], h[2], h[3]); }
}
__device__ __forceinline__ void ph_final_row(const float* x1, const f16_t* yrows, const int* topi, const float* gate, const int* slotpos, const LAS int* pst, const LAS float* tab, float* out, int t, int lane) {
    int rows[TK]; float gw_[TK];
#pragma unroll
    for (int k = 0; k < TK; ++k) { const int f = t * TK + k; rows[k] = pst[topi[f]] + slotpos[f]; gw_[k] = gate[f]; }
    float y[4][8]; float ss = 0.f;
#pragma unroll
    for (int j = 0; j < 4; ++j) {
#pragma unroll
        for (int i = 0; i < 8; ++i) y[j][i] = 0.f;
#pragma unroll
        for (int k = 0; k < TK; ++k) { const f16x8 r = *(const f16x8*)(yrows + (size_t)rows[k] * DM + 8 * lane + 512 * j);
#pragma unroll
            for (int i = 0; i < 8; ++i) y[j][i] += gw_[k] * (float)r[i]; }
#pragma unroll
        for (int i = 0; i < 8; ++i) ss += y[j][i] * y[j][i]; }
    const float r = rsqrtf(wsum(ss) * (1.0f / DM) + 1e-6f);
    const LAS float* tg = tab + (t / SEQ) * 2 * DM;
#pragma unroll
    for (int j = 0; j < 4; ++j) { const int col = 8 * lane + 512 * j;
#pragma unroll
        for (int q = 0; q < 2; ++q) { const f32x4 xv = *(const f32x4*)(x1 + (size_t)t * DM + col + 4 * q);
            const f32x4 g2 = *(const LAS f32x4*)(tg + col + 4 * q), gp = *(const LAS f32x4*)(tg + DM + col + 4 * q);
            f32x4 yv = (f32x4){y[j][4 * q], y[j][4 * q + 1], y[j][4 * q + 2], y[j][4 * q + 3]};
            *(f32x4*)(out + (size_t)t * DM + col + 4 * q) = xv + g2 * (yv * r * gp); } }
}
__device__ __forceinline__ void ph_final_row_h(const f32x4 (&xq)[8], const int (&rows)[TK], const float (&gw_)[TK], const f16_t* yrows, const LAS float* tab, float* out, int t, int lane) {
    float y[4][8]; float ss = 0.f;
#pragma unroll
    for (int j = 0; j < 4; ++j) {
#pragma unroll
        for (int i = 0; i < 8; ++i) y[j][i] = 0.f;
#pragma unroll
        for (int k = 0; k < TK; ++k) { const f16x8 r = *(const f16x8*)(yrows + (size_t)rows[k] * DM + 8 * lane + 512 * j);
#pragma unroll
            for (int i = 0; i < 8; ++i) y[j][i] += gw_[k] * (float)r[i]; }
#pragma unroll
        for (int i = 0; i < 8; ++i) ss += y[j][i] * y[j][i]; }
    const float r = rsqrtf(wsum(ss) * (1.0f / DM) + 1e-6f);
    const LAS float* tg = tab + (t / SEQ) * 2 * DM;
#pragma unroll
    for (int j = 0; j < 4; ++j) { const int col = 8 * lane + 512 * j;
#pragma unroll
        for (int q = 0; q < 2; ++q) { const f32x4 xv = xq[2 * j + q];
            const f32x4 g2 = *(const LAS f32x4*)(tg + col + 4 * q), gp = *(const LAS f32x4*)(tg + DM + col + 4 * q);
            f32x4 yv = (f32x4){y[j][4 * q], y[j][4 * q + 1], y[j][4 * q + 2], y[j][4 * q + 3]};
            *(f32x4*)(out + (size_t)t * DM + col + 4 * q) = xv + g2 * (yv * r * gp); } }
}
__device__ __forceinline__ void ph_router_mfma(const float* h2, const float* wr, LAS float* part, int tok0, int wv, int lane) {
    const int i = lane & 31, kk = lane >> 5, kb = 256 * wv + 128 * kk;
    const f32x4* ap = (const f32x4*)(h2 + (size_t)(tok0 + i) * DM + kb);
    const float* bp = wr + (size_t)kb * NE + i;
    f32x16 acc = {0.f, 0.f, 0.f, 0.f, 0.f, 0.f, 0.f, 0.f, 0.f, 0.f, 0.f, 0.f, 0.f, 0.f, 0.f, 0.f};
#pragma unroll 4
    for (int s4 = 0; s4 < 32; ++s4) { const f32x4 a = ap[s4];
#pragma unroll
        for (int u = 0; u < 4; ++u) acc = __builtin_amdgcn_mfma_f32_32x32x2f32(a[u], bp[(size_t)(4 * s4 + u) * NE], acc, 0, 0, 0); }
#pragma unroll
    for (int r = 0; r < 16; ++r) part[(wv * 32 + ((r & 3) + 8 * (r >> 2) + 4 * kk)) * 32 + i] = acc[r];
}

__device__ __forceinline__ void ph_router_mfma2(const float* h2, const float* wr, LAS float* part, int tok0, int wv, int lane, LAS float* stg, const LAS float* tab, const LAS float* rs2) {
    const int i = lane & 31, kk = lane >> 5, kb = 256 * wv;
    const int lr = lane >> 3, lc = (lane & 7) * 4;
    f32x4 va[8][4];
#pragma unroll
    for (int c = 0; c < 8; ++c)
#pragma unroll
        for (int q = 0; q < 4; ++q) va[c][q] = *(const f32x4*)(h2 + (size_t)(tok0 + 8 * q + lr) * DM + kb + 32 * c + lc);
    const float* bp = wr + (size_t)(kb + 16 * kk) * NE + i;
    f32x16 acc = {0.f, 0.f, 0.f, 0.f, 0.f, 0.f, 0.f, 0.f, 0.f, 0.f, 0.f, 0.f, 0.f, 0.f, 0.f, 0.f};
    float bwn[16];
#pragma unroll
    for (int s = 0; s < 16; ++s) bwn[s] = bp[(size_t)s * NE];
#pragma unroll
    for (int c = 0; c < 8; ++c) {
        float bw[16];
#pragma unroll
        for (int s = 0; s < 16; ++s) bw[s] = bwn[s];
        if (c + 1 < 8) {
#pragma unroll
            for (int s = 0; s < 16; ++s) bwn[s] = bp[(size_t)(32 * (c + 1) + s) * NE]; }
        { const f32x4 t2 = *(const LAS f32x4*)(tab + 2 * DM + kb + 32 * c + lc), t3 = *(const LAS f32x4*)(tab + 3 * DM + kb + 32 * c + lc);
#pragma unroll
          for (int q = 0; q < 4; ++q) *(LAS f32x4*)(stg + (8 * q + lr) * 36 + lc) = va[c][q] * rs2[8 * q + lr] * t2 + t3; }
        asm volatile("s_waitcnt lgkmcnt(0)" ::: "memory");
        f32x4 ar[4];
#pragma unroll
        for (int q = 0; q < 4; ++q) ar[q] = *(const LAS f32x4*)(stg + i * 36 + 16 * kk + 4 * q);
        asm volatile("s_waitcnt lgkmcnt(0)" ::: "memory");
#pragma unroll
        for (int s = 0; s < 16; ++s) acc = __builtin_amdgcn_mfma_f32_32x32x2f32(ar[s >> 2][s & 3], bw[s], acc, 0, 0, 0); }
#pragma unroll
    for (int r = 0; r < 16; ++r) part[(wv * 32 + ((r & 3) + 8 * (r >> 2) + 4 * kk)) * 32 + i] = acc[r];
}

constexpr int N_PHASES = 12;
__global__ void __launch_bounds__(NT, 2) fwd(Args args) {
    extern __shared__ __attribute__((aligned(16))) unsigned char lds[];
    volatile LAS unsigned* MISC = (volatile LAS unsigned*)((LAS unsigned char*)lds + MISC_OFF);
    for (int u = threadIdx.x; u < (LDS_BYTES - MISC_OFF) / 4; u += NT) MISC[u] = 0u;
    __syncthreads();
    { XcdBarrier b0 = xcd_barrier_post((unsigned*)(args.ws + WS_CTL) + CW_BAR, MISC + 8); (void)b0; }
    if (threadIdx.x == 0) { MISC[16] = (unsigned)args.ph_lo; MISC[17] = (unsigned)args.ph_hi; MISC[18] = gridDim.x; }
    const int bx = blockIdx.x;
#define LO ((int)__builtin_amdgcn_readfirstlane((int)((LAS unsigned*)((LAS unsigned char*)lds + MISC_OFF))[16]))
#define HI ((int)__builtin_amdgcn_readfirstlane((int)((LAS unsigned*)((LAS unsigned char*)lds + MISC_OFF))[17]))
#define G ((int)__builtin_amdgcn_readfirstlane((int)((LAS unsigned*)((LAS unsigned char*)lds + MISC_OFF))[18]))
#ifndef REP_PHASE
#define REP_PHASE -1
#endif
#define IN(k) (LO <= (k) && (k) < HI)
#define PHASE(k) if (IN(k)) for (int rep_ = 0; rep_ < (((k) == REP_PHASE) ? 2 : 1); ++rep_)
#define SEAM(k) do { if (IN(k) && IN((k) + 1)) { XcdBarrier bar_; bar_.bar = (unsigned*)WSP(WS_CTL) + CW_BAR; bar_.x = xb_xcc_id(); bar_.st = MISC + 8; xcd_barrier(bar_); } } while (0)

    LAS unsigned long long* PT = (LAS unsigned long long*)((LAS unsigned char*)lds + MISC_OFF + 256);
#pragma unroll
    for (int k = 0; k < 20; ++k) if (threadIdx.x == k) PT[k] = (unsigned long long)args.in[k];
    if (threadIdx.x == 20) PT[20] = (unsigned long long)args.out;
    if (threadIdx.x == 21) PT[21] = (unsigned long long)args.ws;
    __syncthreads();
#define GASP __attribute__((address_space(1)))
#define LDP(k) ((unsigned char*)(GASP unsigned char*)(((unsigned long long)(unsigned)__builtin_amdgcn_readfirstlane((int)(unsigned)(PT[k] >> 32)) << 32) | (unsigned long long)(unsigned)__builtin_amdgcn_readfirstlane((int)(unsigned)PT[k])))
#define WSP(off) (LDP(21) + (off))
#define p_x ((const float*)LDP(0))
#define p_c ((const float*)LDP(1))
#define p_positions ((const int*)LDP(2))
#define p_w_ada ((const float*)LDP(3))
#define p_b_ada ((const float*)LDP(4))
#define p_g_pre_mix ((const float*)LDP(5))
#define p_g_post_mix ((const float*)LDP(6))
#define p_w_in ((const float*)LDP(7))
#define p_conv_w ((const float*)LDP(8))
#define p_g_conv_out ((const float*)LDP(9))
#define p_g_attn_out ((const float*)LDP(10))
#define p_w_out ((const float*)LDP(11))
#define p_g_pre_ffn ((const float*)LDP(12))
#define p_g_post_ffn ((const float*)LDP(13))
#define p_w_router ((const float*)LDP(14))
#define p_b_router ((const float*)LDP(15))
#define p_w_gate_up ((const float*)LDP(16))
#define p_b_gate_up ((const float*)LDP(17))
#define p_w_down ((const float*)LDP(18))
#define p_b_down ((const float*)LDP(19))
#define p_out ((float*)LDP(20))
#define p_adap ((float*)WSP(WS_ADAP))
#define p_ada ((float*)WSP(WS_ADA))
#define p_topi ((int*)WSP(WS_TOPI))
#define p_gate ((float*)WSP(WS_GATE))
#define p_lists ((int*)WSP(WS_LISTS))
#define p_counts ((int*)WSP(WS_CTL) + 2048)
#define p_slotpos ((int*)WSP(WS_SLOT))
#define p_tile_e ((int*)WSP(WS_COUNTS + 1024))
#define p_ntiles_p ((int*)WSP(WS_COUNTS + 2048))
#define p_sel ((int*)WSP(WS_SEL))
#define p_proj ((f16_t*)WSP(WS_PROJ))
#define p_scores ((float*)WSP(WS_SCORES))
#define p_mix ((float*)WSP(WS_MIX))
#define p_x1 ((float*)WSP(WS_X1))
#define p_h2 ((float*)WSP(WS_H2))
#define p_yrows ((f16_t*)WSP(WS_YROWS))
#define p_wtin ((f16_t*)WSP(WS_WTIN))
#define p_wtout ((f16_t*)WSP(WS_WTOUT))
#define p_wtgu ((f16_t*)WSP(WS_WTGU))
#define p_wtdn ((f16_t*)WSP(WS_WTDN))
#define p_h1h ((f16_t*)WSP(WS_H1H))
#define p_mergedh ((f16_t*)WSP(WS_MERGEDH))
#define p_h2h ((f16_t*)WSP(WS_H2H))
#define p_xg ((f16_t*)WSP(WS_XG))
#define p_acth ((f16_t*)WSP(WS_ACTH))
#define p_qh ((f16_t*)WSP(WS_QH))
#define p_kh ((f16_t*)WSP(WS_KH))
#define p_vh ((f16_t*)WSP(WS_VH))
#define p_qih ((f16_t*)WSP(WS_QIH))
#define p_kih ((f16_t*)WSP(WS_KIH))
#define p_wi ((float*)WSP(WS_WI))
#define p_maskp ((unsigned long long*)WSP(WS_MASK))
#define p_opart ((f16_t*)WSP(WS_OPART))
#define p_ostat ((float*)WSP(WS_OSTAT))
#define lane ((int)(threadIdx.x & 63))
#define wave (__builtin_amdgcn_readfirstlane((int)(threadIdx.x >> 6)))
#define gw (bx * 8 + wave)
#define NGW (G * 8)

    PHASE(0) { for (int vb = bx; vb < 24 * ADA_KC; vb += G) nb_ada_part(p_c, p_w_ada, p_adap, vb, lds);
        LAS float* scr = (LAS float*)((LAS unsigned char*)lds + wave * 16896);
        constexpr int NTI = (DM / 64) * (DINP / 64), NTO = (DM / 64) * (DM / 64);
        if (G == 256) {
            const int nada = 24 * ADA_KC;
            const int r0 = (bx >= nada) ? gw - nada * 8 : NTIQ + gw, rs = (bx >= nada) ? (G - nada) * 8 : nada * 8, rend = (bx >= nada) ? NTIQ : NTI + NTO;
            for (int ci = r0; ci < rend; ci += rs) { if (ci < NTI) transpose_item(p_w_in, DM, DIN, p_wtin, scr, DINP / 64, ci, lane); else transpose_item(p_w_out, DM, DM, p_wtout, scr, DM / 64, ci - NTI, lane); } }
        else {
            for (int it = gw; it < NTI; it += NGW) transpose_item(p_w_in, DM, DIN, p_wtin, scr, DINP / 64, it, lane);
            for (int it = gw; it < NTO; it += NGW) transpose_item(p_w_out, DM, DM, p_wtout, scr, DM / 64, it, lane); }
        __syncthreads(); }
    SEAM(0);
    PHASE(1) { LAS float* tab = (LAS float*)((LAS unsigned char*)lds);
        for (int i = threadIdx.x; i < NB * DM; i += NT) { const int b = i / DM, col = i % DM; float sc = p_b_ada[A_SC1 + col], sh = p_b_ada[A_SH1 + col];
#pragma unroll
            for (int kc = 0; kc < ADA_KC; ++kc) { sc += p_adap[(size_t)(kc * 2 + b) * (6 * DM) + A_SC1 + col]; sh += p_adap[(size_t)(kc * 2 + b) * (6 * DM) + A_SH1 + col]; }
            tab[b * 2 * DM + col] = p_g_pre_mix[col] * (1.0f + sc); tab[b * 2 * DM + DM + col] = sh; }
        for (int i = bx * NT + threadIdx.x; i < NB * 6 * DM; i += G * NT) { float a = p_b_ada[i % (6 * DM)];
#pragma unroll
            for (int kc = 0; kc < ADA_KC; ++kc) a += p_adap[(size_t)kc * 2 * (6 * DM) + i];
            p_ada[i] = a; }
        __syncthreads();
        for (int t = gw; t < NTOK; t += NGW) ph_h1_row(p_x, tab, p_h1h, t, lane);
        __syncthreads(); }
    SEAM(1);
#define CONV_ITEM(it_) do { const unsigned it__ = (it_); \
        if (it__ < 512u) { const int e = (int)(it__ >> 4), part = (int)(it__ & 15); \
            tq_run16(p_w_gate_up + (size_t)e * DM * 2 * DFF, (unsigned char*)p_wtgu + (size_t)e * 2 * DFF * DM, DM, 2 * DFF, 32 * (part * 8 + wave), scq_, lane, 32.0f); \
            asm volatile("s_waitcnt vmcnt(0)" ::: "memory"); __syncthreads(); \
            if (threadIdx.x == 0) __hip_atomic_fetch_add(ctlw_ + CW_RDY0 + 64 * e, 1u, __ATOMIC_RELAXED, __HIP_MEMORY_SCOPE_AGENT); } \
        else if (it__ < 768u) { const int e = (int)((it__ - 512u) >> 3), part = (int)((it__ - 512u) & 7); \
            tq_run16(p_w_down + (size_t)e * DFF * DM, (unsigned char*)p_wtdn + (size_t)e * DM * DFF, DFF, DM, 32 * (part * 8 + wave), scq_, lane, 32.0f); } } while (0)
    constexpr int NC1 = 4, Q4 = 2, Q5 = 2;
    const bool cv1 = (G == 256) && (((bx >> 3) & 7) < NC1);
    const unsigned c1 = (unsigned)__builtin_amdgcn_readfirstlane((bx >> 6) * (8 * NC1) + ((bx >> 3) & 7) * 8 + (bx & 7));
    const unsigned conv_done = (G == 256) ? 32u * NC1 * (Q4 + Q5) : 0u;
    PHASE(2) {
        if (G == 256 && bx >= 224) {
            unsigned* ctlw_ = (unsigned*)WSP(WS_CTL); LAS float* scq_ = (LAS float*)((LAS unsigned char*)lds + wave * 16896);
            CONV_ITEM(736u + (unsigned)(bx - 224));
            asm volatile("s_waitcnt vmcnt(0)" ::: "memory"); __syncthreads(); }
        pg8::Gemm g{p_h1h, p_wtin, NTOK, DINP, DM}; pg8::StaticOrder S; S.init(NTOK, DINP, G, bx);
        pg8::EpiF16G E{p_proj, DIN, DIN};
        pg8::gemm_phase<pg8::EpiF16G, pg8::StaticOrder>((LAS unsigned char*)lds, g, S, E); }
    SEAM(2);
    PHASE(3) { for (int t = gw; t < NTOK; t += NGW) ph_rope_conv_row(p_proj, p_positions, p_conv_w, p_g_conv_out, p_mergedh, p_qh, p_kh, p_vh, p_qih, p_kih, p_wi, t, lane); }
    const bool th4 = IN(3) && IN(4) && !cv1 && (REP_PHASE < 0); unsigned tk4 = 0u;
    if (th4 && threadIdx.x == 0) { unsigned z_; asm volatile("v_mov_b32 %0, 0" : "=v"(z_)); tk4 = __hip_atomic_fetch_add((unsigned*)WSP(WS_CTL) + CW_Q4 + z_, 1u, __ATOMIC_RELAXED, __HIP_MEMORY_SCOPE_AGENT); }
    SEAM(3);
    PHASE(4) { unsigned* ctlw_ = (unsigned*)WSP(WS_CTL); LAS float* scq_ = (LAS float*)((LAS unsigned char*)lds + wave * 16896);
        if (cv1) {
#pragma unroll 1
            for (unsigned j = 0; j < (unsigned)Q4; ++j) CONV_ITEM(c1 + 32u * NC1 * j);
            asm volatile("s_waitcnt vmcnt(0)" ::: "memory"); __syncthreads(); }
#pragma unroll 1
        for (int n = 0;; ++n) {
            if (threadIdx.x == 0) MISC[30 + (n & 1)] = (n == 0 && th4) ? tk4 : __hip_atomic_fetch_add(ctlw_ + CW_Q4, 1u, __ATOMIC_RELAXED, __HIP_MEMORY_SCOPE_AGENT);
            asm volatile("s_waitcnt lgkmcnt(0)" ::: "memory"); __syncthreads();
            const int k = __builtin_amdgcn_readfirstlane((int)MISC[30 + (n & 1)]);
            if (k >= 512) break;
            const int b = k & 1, p = 255 - (k >> 1);
            ph_scores_block(p_qih, p_kih, p_wi, p_scores, b * SEQ + 16 * p, (LAS unsigned char*)lds);
            asm volatile("s_waitcnt vmcnt(0)" ::: "memory"); __syncthreads();
#pragma unroll 1
            for (int hq = 0; hq < 2; ++hq) ph_select_row(p_scores, p_maskp, b * SEQ + 16 * p + 2 * wave + hq, lane); } }
    const bool th5 = IN(4) && IN(5) && !cv1 && (REP_PHASE < 0); unsigned tk5 = 0u;
    if (th5 && threadIdx.x == 0) { unsigned z_; asm volatile("v_mov_b32 %0, 0" : "=v"(z_)); tk5 = __hip_atomic_fetch_add((unsigned*)WSP(WS_CTL) + CW_Q5 + z_, 1u, __ATOMIC_RELAXED, __HIP_MEMORY_SCOPE_AGENT); }
    SEAM(4);
    PHASE(5) { unsigned* ctlw_ = (unsigned*)WSP(WS_CTL); LAS float* scq_ = (LAS float*)((LAS unsigned char*)lds + wave * 16896);
        if (cv1) {
#pragma unroll 1
            for (unsigned j = (unsigned)Q4; j < (unsigned)(Q4 + Q5); ++j) CONV_ITEM(c1 + 32u * NC1 * j);
            asm volatile("s_waitcnt vmcnt(0)" ::: "memory"); __syncthreads(); }
#pragma unroll 1
        for (int n = 0;; ++n) {
            if (threadIdx.x == 0) MISC[30 + (n & 1)] = (n == 0 && th5) ? tk5 : __hip_atomic_fetch_add(ctlw_ + CW_Q5, 1u, __ATOMIC_RELAXED, __HIP_MEMORY_SCOPE_AGENT);
            asm volatile("s_waitcnt lgkmcnt(0)" ::: "memory"); __syncthreads();
            const int k = __builtin_amdgcn_readfirstlane((int)MISC[30 + (n & 1)]);
            if (k >= 512) break;
            att::attn_block(att_ref_sorted(k, p_qh, p_kh, p_vh, p_maskp, p_opart, p_ostat), (char*)lds); } }
    SEAM(5);
    PHASE(6) { for (int t = gw; t < NTOK; t += 4 * NGW) ph_merge_rows4(p_opart, p_ostat, p_g_attn_out, p_mergedh, t, NGW, lane); }
    SEAM(6);
    PHASE(7) { pg8::Gemm g{p_mergedh, p_wtout, NTOK, DM, DM}; pg8::StaticOrder S; S.init(NTOK, DM, G, bx);
        pg8::EpiBf16G E{(f16_t*)p_mix, DM, DM};
        pg8::gemm_phase<pg8::EpiBf16G, pg8::StaticOrder>((LAS unsigned char*)lds, g, S, E); }
    SEAM(7);
    PHASE(8) { LAS float* tab = (LAS float*)((LAS unsigned char*)lds); LAS float* part = tab + 4 * DM; LAS float* lg = part + 8 * 32 * 32;
        LAS int* cnt = (LAS int*)(lg + 32 * NE); LAS int* basee = cnt + NE; LAS int* rnk = basee + NE; LAS int* eid = rnk + 32 * TK;
        for (int un = bx; un < NTOK / 32; un += G) { const int tok0 = un * 32, b = tok0 / SEQ;
            for (int col = threadIdx.x; col < DM; col += NT) { tab[col] = p_ada[b * 6 * DM + A_GT1 + col]; tab[DM + col] = p_g_post_mix[col];
                tab[2 * DM + col] = p_g_pre_ffn[col] * (1.0f + p_ada[b * 6 * DM + A_SC2 + col]); tab[3 * DM + col] = p_ada[b * 6 * DM + A_SH2 + col]; }
            if (threadIdx.x < NE) cnt[threadIdx.x] = 0;
            __syncthreads();
            for (int i = 0; i < 4; ++i) ph_post_row(p_x, (const f16_t*)p_mix, tab, p_x1, (LAS float*)((LAS unsigned char*)lds + 122880) + 4 * wave + i, (unsigned char*)p_h2h, tok0 + 4 * wave + i, lane);
            asm volatile("s_waitcnt vmcnt(0)" ::: "memory"); __syncthreads();
            ph_router_mfma2(p_x1, p_w_router, part, tok0, wave, lane, (LAS float*)((LAS unsigned char*)lds + 81920 + wave * 4608), tab, (const LAS float*)((LAS unsigned char*)lds + 122880));
            __syncthreads();
            { const int tk = threadIdx.x >> 4, e0 = (threadIdx.x & 15) * 2; float a0 = p_b_router[e0], a1 = p_b_router[e0 + 1];
#pragma unroll
              for (int w8 = 0; w8 < 8; ++w8) { a0 += part[(w8 * 32 + tk) * 32 + e0]; a1 += part[(w8 * 32 + tk) * 32 + e0 + 1]; }
              lg[tk * NE + e0] = a0; lg[tk * NE + e0 + 1] = a1; }
            __syncthreads();
            if (threadIdx.x < 32) { const int tk = threadIdx.x; float v[NE];
#pragma unroll
                for (int i = 0; i < NE; ++i) v[i] = lg[tk * NE + i];
                int idx[TK]; float val[TK];
#pragma unroll
                for (int k = 0; k < TK; ++k) { float best = -INFINITY; int bi = 0;
#pragma unroll
                    for (int i = 0; i < NE; ++i) { const bool take = v[i] > best; best = take ? v[i] : best; bi = take ? i : bi; }
                    idx[k] = bi; val[k] = best;
#pragma unroll
                    for (int i = 0; i < NE; ++i) v[i] = (i == bi) ? -INFINITY : v[i]; }
                float sm = 0.f, ex[TK];
#pragma unroll
                for (int k = 0; k < TK; ++k) { ex[k] = __expf(val[k] - val[0]); sm += ex[k]; }
#pragma unroll
                for (int k = 0; k < TK; ++k) { const int f = (tok0 + tk) * TK + k; p_topi[f] = idx[k]; p_gate[f] = ex[k] / sm;
                    eid[tk * TK + k] = idx[k]; rnk[tk * TK + k] = atomicAdd((int*)&cnt[idx[k]], 1); } }
            __syncthreads();
            if (threadIdx.x < NE) basee[threadIdx.x] = atomicAdd(&p_counts[threadIdx.x], cnt[threadIdx.x]);
            __syncthreads();
            if (threadIdx.x < 32 * TK) { const int f = tok0 * TK + threadIdx.x, e = eid[threadIdx.x], pos = basee[e] + rnk[threadIdx.x];
                p_lists[(size_t)e * NTOK + pos] = f; p_slotpos[f] = pos; }
            __syncthreads(); } }
    SEAM(8);
#define T_TE ((LAS int*)((LAS unsigned char*)lds + MISC_OFF + 1024))
#define T_TJ ((LAS int*)((LAS unsigned char*)lds + MISC_OFF + 1024 + 640))
#define T_PST ((LAS int*)((LAS unsigned char*)lds + MISC_OFF + 1024 + 1280))
#define T_CN ((LAS int*)((LAS unsigned char*)lds + MISC_OFF + 1024 + 1280 + 160))
#define T_NT ((LAS int*)((LAS unsigned char*)lds + MISC_OFF + 1024 + 1280 + 160 + 128))
    PHASE(9) {
        if (threadIdx.x < 64) {
            const int e = lane & 31; const int cc = p_counts[e], nt_e = (cc + 255) >> 8; int inc = nt_e;
#pragma unroll
            for (int d = 1; d < 32; d <<= 1) { const int o = __shfl_up(inc, d, 32); if (e >= d) inc += o; }
            const int pre = inc - nt_e;
            if (lane < 32) { T_CN[e] = cc; T_PST[e] = pre * 256;
                for (int j = 0; j < nt_e; ++j) { T_TE[pre + j] = e; T_TJ[pre + j] = j; }
                if (e == NE - 1) { T_PST[NE] = inc * 256; T_NT[0] = inc; } } }
        __syncthreads();
        unsigned* ctlw = (unsigned*)WSP(WS_CTL);
        constexpr int NCV = 2;
        const bool conv_all = (G != 256);
        if (conv_all || ((bx >> 3) & 7) < NCV) {
            LAS float* scq = (LAS float*)((LAS unsigned char*)lds + wave * 16896);
            const int crank = (bx >> 6) * (8 * NCV) + ((bx >> 3) & 7) * 8 + (bx & 7);
            unsigned* ctlw_ = ctlw; LAS float* scq_ = scq;
#pragma unroll 1
            for (unsigned it = conv_all ? (unsigned)bx : conv_done + (unsigned)__builtin_amdgcn_readfirstlane(crank); it < (conv_all ? 768u : 736u); it += conv_all ? (unsigned)G : 32u * NCV) CONV_ITEM(it);
            asm volatile("s_waitcnt vmcnt(0)" ::: "memory"); __syncthreads();
        }
        pg8::Gemm g{p_h2h, p_wtgu, PMAX, 2 * DFF, DM / 2};
        pg8::DynOrderG S{2 * DFF / 256, T_NT[0], T_TE, T_TJ, T_CN, p_lists, (size_t)2 * DFF * DM, ctlw + CW_XQ, ctlw + CW_RDY0, (conv_done >= 512u) ? 0u : 16u, ctlw + CW_TMO2, MISC + 26, -1, xb_xcc_id() & 7u, 0u, false};
        pg8::EpiSwigluQ E{(unsigned char*)p_acth, DFF, p_b_gate_up, 2 * DFF};
        pg8::gemm_phase<pg8::EpiSwigluQ, pg8::DynOrderG, false, true>((LAS unsigned char*)lds, g, S, E); }
    const bool th10 = IN(9) && IN(10) && (REP_PHASE < 0); const unsigned xq10 = xb_xcc_id() & 7u; unsigned pend10 = 0u;
    if (th10 && threadIdx.x == 0) { unsigned z_; asm volatile("v_mov_b32 %0, 0" : "=v"(z_)); pend10 = __hip_atomic_fetch_add((unsigned*)WSP(WS_CTL) + CW_XQ + 256 + 32 * xq10 + z_, 1u, __ATOMIC_RELAXED, __HIP_MEMORY_SCOPE_AGENT); }
    SEAM(9);
    const bool hoist11 = IN(10) && IN(11) && (NGW * 4 == NTOK) && (REP_PHASE < 0);
    constexpr int HX = 3;
    f32x4 xh[4][8]; int rowsh[4][TK]; float gwh[4][TK];
    PHASE(10) { pg8::Gemm g{p_acth, p_wtdn, PMAX, DM, DFF / 2}; unsigned* ctlw = (unsigned*)WSP(WS_CTL);
        pg8::DynOrderD S{DM / 256, T_NT[0], T_TE, T_TJ, T_CN, p_lists, (size_t)DM * DFF, ctlw + CW_XQ + 256, ctlw + CW_RDY0, 0u, ctlw + CW_TMO2, MISC + 26, -1, xq10, pend10, th10};
        pg8::EpiF16Bias E{p_yrows, DM, p_b_down, DM};
        pg8::gemm_phase<pg8::EpiF16Bias, pg8::DynOrderD, false, true>((LAS unsigned char*)lds, g, S, E);
        if (hoist11) { LAS float* tab = (LAS float*)((LAS unsigned char*)lds + 1024);
            for (int i = threadIdx.x; i < NB * DM; i += NT) { const int b = i / DM, col = i % DM; tab[b * 2 * DM + col] = p_ada[b * 6 * DM + A_GT2 + col]; tab[b * 2 * DM + DM + col] = p_g_post_ffn[col]; }
#pragma unroll
            for (int r = 0; r < 4; ++r) { const int t = gw + NGW * r;
#pragma unroll
                for (int k = 0; k < TK; ++k) { const int f = t * TK + k; rowsh[r][k] = T_PST[p_topi[f]] + p_slotpos[f]; gwh[r][k] = p_gate[f]; }
                if (r < HX) {
#pragma unroll
                    for (int j = 0; j < 4; ++j)
#pragma unroll
                        for (int q = 0; q < 2; ++q) xh[r][2 * j + q] = *(const f32x4*)(p_x1 + (size_t)t * DM + 8 * lane + 512 * j + 4 * q); } }
            __syncthreads(); } }
    SEAM(10);
    PHASE(11) { LAS float* tab = (LAS float*)((LAS unsigned char*)lds + 1024);
        if (hoist11) {
#pragma unroll
            for (int r = 0; r < 4; ++r) { const int t = gw + NGW * r;
                if (r >= HX) {
#pragma unroll
                    for (int j = 0; j < 4; ++j)
#pragma unroll
                        for (int q = 0; q < 2; ++q) xh[r][2 * j + q] = *(const f32x4*)(p_x1 + (size_t)t * DM + 8 * lane + 512 * j + 4 * q); }
                ph_final_row_h(xh[r], rowsh[r], gwh[r], p_yrows, tab, p_out, t, lane); } }
        else {
        for (int i = threadIdx.x; i < NB * DM; i += NT) { const int b = i / DM, col = i % DM; tab[b * 2 * DM + col] = p_ada[b * 6 * DM + A_GT2 + col]; tab[b * 2 * DM + DM + col] = p_g_post_ffn[col]; }
        __syncthreads();
        for (int t = gw; t < NTOK; t += NGW) ph_final_row(p_x1, p_yrows, p_topi, p_gate, p_slotpos, T_PST, tab, p_out, t, lane); } }
#undef T_TE
#undef T_TJ
#undef T_PST
#undef T_CN
#undef T_NT
#undef IN
#undef PHASE
#undef SEAM
#undef LO
#undef HI
#undef G
#undef NGW
}
#undef lane
#undef wave
#undef gw

extern "C" void kernel_launch(void* const* d_in, const int* in_sizes, int n_in, void* d_out, int out_size, void* d_ws, size_t ws_size, hipStream_t stream) {
    static int grid = 0;
    if (grid == 0) {
        if (n_in != 20 || ws_size < WS_END) { fprintf(stderr, "kernel_launch: unexpected n_in %d or ws_size %zu\n", n_in, ws_size); grid = -1; return; }
        int dev = 0, cus = 0, per_cu = 0;
        if (hipGetDevice(&dev) != hipSuccess || hipDeviceGetAttribute(&cus, hipDeviceAttributeMultiprocessorCount, dev) != hipSuccess) { grid = -1; return; }
        if (hipFuncSetAttribute((const void*)fwd, hipFuncAttributeMaxDynamicSharedMemorySize, LDS_BYTES) != hipSuccess) { fprintf(stderr, "kernel_launch: hipFuncSetAttribute failed\n"); grid = -1; return; }
        if (hipOccupancyMaxActiveBlocksPerMultiprocessor(&per_cu, (const void*)fwd, NT, LDS_BYTES) != hipSuccess || per_cu < 1) fprintf(stderr, "kernel_launch: occupancy query says %d\n", per_cu);
        (void)hipGetLastError();
        grid = cus;
    }
    if (grid < 0) return;
    if (hipMemsetAsync((char*)d_ws + WS_CTL, 0, CTL_ZERO_BYTES, stream) != hipSuccess) return;
    Args a{};
    for (int i = 0; i < 20; ++i) a.in[i] = d_in[i];
    a.out = (float*)d_out; a.ws = (unsigned char*)d_ws; a.ph_lo = 0; a.ph_hi = N_PHASES;
    hipLaunchKernelGGL(fwd, dim3(grid), dim3(NT), LDS_BYTES, stream, a);
}
```
